# Optimizing an MI355X kernel written in HIP

```python
import jax, jax.numpy as jnp
from jax import lax
import numpy as np

D_MODEL = 2048
BATCH = 2
SEQ = 4096
DEPTH = 4

N_MEM = 256
N_MEM_HEADS = 4
MEM_HEAD_DIM = D_MODEL // N_MEM_HEADS

HEAD_DIM_A = 128
N_HEADS_A = (D_MODEL // 2) // HEAD_DIM_A
WIDTH_A = N_HEADS_A * HEAD_DIM_A
DILATED_BRANCHES = ((128, 1), (512, 4), (2048, 16))

HEAD_DIM_B = 64
N_Q_HEADS_B = (D_MODEL // 2) // HEAD_DIM_B
N_KV_HEADS_B = max(1, N_Q_HEADS_B // 8)
WIDTH_B = N_Q_HEADS_B * HEAD_DIM_B
KV_WIDTH_B = N_KV_HEADS_B * HEAD_DIM_B
WINDOW_B = 128

MIX_WIDTH = WIDTH_A + WIDTH_B
SPLITS = (WIDTH_A, 2 * WIDTH_A, 3 * WIDTH_A, 3 * WIDTH_A + WIDTH_B,
          3 * WIDTH_A + WIDTH_B + KV_WIDTH_B)
IN_WIDTH = 3 * WIDTH_A + WIDTH_B + 2 * KV_WIDTH_B

ROPE_THETA = 500000.0
ROT_DIM_A = HEAD_DIM_A // 4
ROT_DIM_B = HEAD_DIM_B // 4

D_FF = 4 * D_MODEL
BLOCK = 128
ALPHA = (2 * DEPTH) ** 0.25
BETA = (8 * DEPTH) ** -0.25
LN_EPS = 1e-5
RMS_EPS = 1e-6
NEG_INF = -1e30

kernel_name = 'hybrid_dilated_swa_sink_deepnorm'


def _layernorm(x, g, b):
    xf = x.astype(jnp.float32)
    mu = xf.mean(-1, keepdims=True)
    var = jnp.square(xf - mu).mean(-1, keepdims=True)
    return ((xf - mu) * lax.rsqrt(var + LN_EPS) * g + b).astype(x.dtype)


def _rms_gain(y, g):
    yf = y.astype(jnp.float32)
    return yf * lax.rsqrt(jnp.mean(yf * yf, -1, keepdims=True) + RMS_EPS) * g


def _rope_tables(positions, rot_dim):
    inv_freq = ROPE_THETA ** (-jnp.arange(0, rot_dim, 2, dtype=jnp.float32) / rot_dim)
    ang = positions.astype(jnp.float32)[:, :, None] * inv_freq
    return jnp.cos(ang)[:, :, None, :], jnp.sin(ang)[:, :, None, :]


def _partial_rope(t, cos, sin):
    half = cos.shape[-1]
    t1 = t[..., :half].astype(jnp.float32)
    t2 = t[..., half:2 * half].astype(jnp.float32)
    rot = jnp.concatenate([t1 * cos - t2 * sin, t2 * cos + t1 * sin], -1).astype(t.dtype)
    return jnp.concatenate([rot, t[..., 2 * half:]], -1)


def _banded_stats(q, k, v, max_dist, scale):
    B, L, G, R, Dh = q.shape
    nb = L // BLOCK
    qb = q.reshape(B, nb, BLOCK, G, R, Dh).astype(jnp.float32)

    def two_blocks(t):
        tb = t.reshape(B, nb, BLOCK, G, Dh).astype(jnp.float32)
        prev = jnp.pad(tb, ((0, 0), (1, 0), (0, 0), (0, 0), (0, 0)))[:, :-1]
        return jnp.concatenate([prev, tb], axis=2)

    k2, v2 = two_blocks(k), two_blocks(v)
    s = jnp.einsum('bnqgrd,bnkgd->bngrqk', qb, k2) * scale
    q_idx = jnp.arange(BLOCK)[:, None] + BLOCK
    k_idx = jnp.arange(2 * BLOCK)[None, :]
    dist = q_idx - k_idx
    in_band = (dist >= 0) & (dist <= max_dist)
    has_prev = (jnp.arange(nb)[:, None, None] > 0) | (k_idx[None] >= BLOCK)
    valid = in_band[None] & has_prev
    s = jnp.where(valid[None, :, None, None], s, NEG_INF)
    m = s.max(-1)
    p = jnp.exp(s - m[..., None])
    l = p.sum(-1)
    acc = jnp.einsum('bngrqk,bnkgd->bnqgrd', p, v2)
    m = m.transpose(0, 1, 4, 2, 3).reshape(B, L, G, R)
    l = l.transpose(0, 1, 4, 2, 3).reshape(B, L, G, R)
    return m, l, acc.reshape(B, L, G, R, Dh)


def _to_strided(t, d, padded_len):
    B, S, H, Dh = t.shape
    Ld = S // d
    t = t.reshape(B, Ld, d, H, Dh).transpose(0, 2, 1, 3, 4).reshape(B * d, Ld, H, Dh)
    return jnp.pad(t, ((0, 0), (0, padded_len - Ld), (0, 0), (0, 0)))


def _from_strided(t, B, d, Ld):
    t = t[:, :Ld]
    t = t.reshape((B, d, Ld) + t.shape[2:])
    t = jnp.swapaxes(t, 1, 2)
    return t.reshape((B, d * Ld) + t.shape[3:])


def _dilated_attention(q, k, v):
    B, S, H, Dh = q.shape
    ms, ls, accs = [], [], []
    for window, d in DILATED_BRANCHES:
        Ld = S // d
        Lp = -(-Ld // BLOCK) * BLOCK
        m, l, acc = _banded_stats(_to_strided(q, d, Lp)[:, :, :, None, :],
                                  _to_strided(k, d, Lp), _to_strided(v, d, Lp),
                                  window // d, Dh ** -0.5)
        ms.append(_from_strided(m, B, d, Ld))
        ls.append(_from_strided(l, B, d, Ld))
        accs.append(_from_strided(acc, B, d, Ld))
    m = jnp.stack(ms)
    l = jnp.stack(ls)
    acc = jnp.stack(accs)
    c = jnp.exp(m - m.max(0, keepdims=True))
    num = (acc * c[..., None]).sum(0)
    den = (l * c).sum(0)
    return (num / den[..., None]).reshape(B, S, H * Dh)


def _sink_window_gqa(q, k, v, sinks):
    B, S, Hq, Dh = q.shape
    G = k.shape[2]
    R = Hq // G
    m, l, acc = _banded_stats(q.reshape(B, S, G, R, Dh), k, v, WINDOW_B - 1, Dh ** -0.5)
    sink = sinks.astype(jnp.float32).reshape(G, R)
    m2 = jnp.maximum(m, sink)
    c = jnp.exp(m - m2)
    den = l * c + jnp.exp(sink - m2)
    return (acc * (c / den)[..., None]).reshape(B, S, Hq * Dh)


def _hybrid_mixer(x, cos_a, sin_a, cos_b, sin_b, w_in, gn_a, gn_b, sinks, w_out):
    B, S, _ = x.shape
    h = x @ w_in
    qa, ka, va, qb, kb, vb = jnp.split(h, SPLITS, axis=-1)
    qa = _partial_rope(qa.reshape(B, S, N_HEADS_A, HEAD_DIM_A), cos_a, sin_a)
    ka = _partial_rope(ka.reshape(B, S, N_HEADS_A, HEAD_DIM_A), cos_a, sin_a)
    va = va.reshape(B, S, N_HEADS_A, HEAD_DIM_A)
    qb = _partial_rope(qb.reshape(B, S, N_Q_HEADS_B, HEAD_DIM_B), cos_b, sin_b)
    kb = _partial_rope(kb.reshape(B, S, N_KV_HEADS_B, HEAD_DIM_B), cos_b, sin_b)
    vb = vb.reshape(B, S, N_KV_HEADS_B, HEAD_DIM_B)
    ya = _dilated_attention(qa, ka, va)
    yb = _sink_window_gqa(qb, kb, vb, sinks)
    y = jnp.concatenate([_rms_gain(ya, gn_a), _rms_gain(yb, gn_b)], -1).astype(x.dtype)
    return y @ w_out


def _memory_attention(x, mem, w_q, w_kv, w_o):
    B, S, _ = x.shape
    q = (x @ w_q).reshape(B, S, N_MEM_HEADS, MEM_HEAD_DIM).astype(jnp.float32)
    k, v = jnp.split(mem @ w_kv, 2, axis=-1)
    k = k.reshape(B, -1, N_MEM_HEADS, MEM_HEAD_DIM).astype(jnp.float32)
    v = v.reshape(B, -1, N_MEM_HEADS, MEM_HEAD_DIM).astype(jnp.float32)
    p = jax.nn.softmax(jnp.einsum('bshd,bmhd->bhsm', q, k) * MEM_HEAD_DIM ** -0.5, axis=-1)
    o = jnp.einsum('bhsm,bmhd->bshd', p, v).reshape(B, S, D_MODEL).astype(x.dtype)
    return o @ w_o


def _sq_relu_mlp(x, w_up, w_down):
    h = jax.nn.relu(x @ w_up)
    return (h * h) @ w_down


def setup_inputs(seed: int = 0) -> dict:
    key = jax.random.key(seed)
    ks = jax.random.split(key, 20)
    f32 = jnp.float32

    def nrm(k, shape, scale):
        return jax.random.normal(k, shape, f32) * scale

    def gain(k, shape):
        return 1.0 + 0.02 * jax.random.normal(k, shape, f32)

    x = nrm(ks[0], (BATCH, SEQ, D_MODEL), 1.0)
    mem = nrm(ks[1], (BATCH, N_MEM, D_MODEL), 1.0)
    positions = (jnp.arange(SEQ, dtype=jnp.int32)[None, :]
                 + jax.random.randint(ks[2], (BATCH, 1), 0, 4096, dtype=jnp.int32))
    in_col_scale = jnp.concatenate([
        jnp.ones((2 * WIDTH_A,), f32), jnp.full((WIDTH_A,), BETA, f32),
        jnp.ones((WIDTH_B + KV_WIDTH_B,), f32), jnp.full((KV_WIDTH_B,), BETA, f32)])
    w_in = nrm(ks[3], (DEPTH, D_MODEL, IN_WIDTH), D_MODEL ** -0.5) * in_col_scale
    gn_a = gain(ks[4], (DEPTH, WIDTH_A))
    gn_b = gain(ks[5], (DEPTH, WIDTH_B))
    sinks = nrm(ks[6], (DEPTH, N_Q_HEADS_B), 0.5)
    w_out = nrm(ks[7], (DEPTH, MIX_WIDTH, D_MODEL), BETA * MIX_WIDTH ** -0.5)
    ln_mix_g = gain(ks[8], (DEPTH, D_MODEL))
    ln_mix_b = nrm(ks[9], (DEPTH, D_MODEL), 0.02)
    w_mq = nrm(ks[10], (DEPTH, D_MODEL, D_MODEL), D_MODEL ** -0.5)
    kv_col_scale = jnp.concatenate([jnp.ones((D_MODEL,), f32), jnp.full((D_MODEL,), BETA, f32)])
    w_mkv = nrm(ks[11], (DEPTH, D_MODEL, 2 * D_MODEL), D_MODEL ** -0.5) * kv_col_scale
    w_mo = nrm(ks[12], (DEPTH, D_MODEL, D_MODEL), BETA * D_MODEL ** -0.5)
    ln_mem_g = gain(ks[13], (DEPTH, D_MODEL))
    ln_mem_b = nrm(ks[14], (DEPTH, D_MODEL), 0.02)
    w_up = nrm(ks[15], (DEPTH, D_MODEL, D_FF), D_MODEL ** -0.5)
    w_down = nrm(ks[16], (DEPTH, D_FF, D_MODEL), BETA * D_FF ** -0.5)
    ln_ff_g = gain(ks[17], (DEPTH, D_MODEL))
    ln_ff_b = nrm(ks[18], (DEPTH, D_MODEL), 0.02)
    return {'x': x, 'mem': mem, 'positions': positions, 'w_in': w_in, 'gn_a': gn_a,
            'gn_b': gn_b, 'sinks': sinks, 'w_out': w_out, 'ln_mix_g': ln_mix_g,
            'ln_mix_b': ln_mix_b, 'w_mq': w_mq, 'w_mkv': w_mkv, 'w_mo': w_mo,
            'ln_mem_g': ln_mem_g, 'ln_mem_b': ln_mem_b, 'w_up': w_up, 'w_down': w_down,
            'ln_ff_g': ln_ff_g, 'ln_ff_b': ln_ff_b}


def reference(x, mem, positions, w_in, gn_a, gn_b, sinks, w_out, ln_mix_g, ln_mix_b,
              w_mq, w_mkv, w_mo, ln_mem_g, ln_mem_b, w_up, w_down, ln_ff_g, ln_ff_b):
    cos_a, sin_a = _rope_tables(positions, ROT_DIM_A)
    cos_b, sin_b = _rope_tables(positions, ROT_DIM_B)
    for i in range(DEPTH):
        y = _hybrid_mixer(x, cos_a, sin_a, cos_b, sin_b, w_in[i], gn_a[i], gn_b[i],
                          sinks[i], w_out[i])
        x = _layernorm(ALPHA * x + y, ln_mix_g[i], ln_mix_b[i])
        y = _memory_attention(x, mem, w_mq[i], w_mkv[i], w_mo[i])
        x = _layernorm(ALPHA * x + y, ln_mem_g[i], ln_mem_b[i])
        y = _sq_relu_mlp(x, w_up[i], w_down[i])
        x = _layernorm(ALPHA * x + y, ln_ff_g[i], ln_ff_b[i])
    return x
```

```cpp
#include <hip/hip_runtime.h>
#include <cstdio>
#include <cstdint>
#include <cmath>

#ifndef MK_PER_PHASE_LAUNCH
#define MK_PER_PHASE_LAUNCH 1
#endif

#define LAS __attribute__((address_space(3)))
#define GAS __attribute__((address_space(1)))
typedef unsigned short bf16_t;
typedef short bf16x8 __attribute__((ext_vector_type(8)));
typedef short s16x4 __attribute__((ext_vector_type(4)));
typedef float f32x4 __attribute__((ext_vector_type(4)));
typedef float f32x2 __attribute__((ext_vector_type(2)));
typedef unsigned u32x4 __attribute__((ext_vector_type(4)));
typedef unsigned u32x2 __attribute__((ext_vector_type(2)));
typedef GAS unsigned gu32;

constexpr int D = 2048, NB = 2, SEQ = 4096, M = NB * SEQ, DEPTH = 4, NMEM = 256, FF = 8192;
constexpr int INW = 4352;
constexpr int QA0 = 0, KA0 = 1024, VA0 = 2048, QB0 = 3072, KB0 = 4096, VB0 = 4224;
constexpr float ALPHA = 1.681792830507429f;
constexpr float LN_EPS = 1e-5f, RMS_EPS = 1e-6f;
constexpr float LOG2E = 1.4426950408889634f;
constexpr float QSA = 0.08838834764831845f * LOG2E;
constexpr float QSB = 0.125f * LOG2E;
constexpr float QSM = 0.04419417382415922f * LOG2E;

constexpr size_t MiB = 1u << 20;
constexpr size_t WS_CTL = 0, CTL_ZERO_BYTES = 1 * MiB;
constexpr size_t WS_TABA = 1 * MiB;
constexpr size_t WS_TABB = 2 * MiB;
constexpr size_t WS_MEMB = 3 * MiB;
constexpr size_t WS_STAT = 5 * MiB;
constexpr size_t WS_KV = 8 * MiB;
constexpr size_t WS_KQT = 24 * MiB;
constexpr size_t WS_VOT = 56 * MiB;
constexpr size_t WS_XB = 88 * MiB;
constexpr size_t WS_PRE = 120 * MiB;
constexpr size_t WS_P = 184 * MiB;
constexpr size_t WS_H = 208 * MiB;
constexpr size_t WS_OA = 276 * MiB;
constexpr size_t WS_OB = 324 * MiB;
constexpr size_t WS_Y = 340 * MiB;
constexpr size_t WS_HID = 208 * MiB;
constexpr size_t WS_W = 384 * MiB;
constexpr size_t WL = 121 * MiB;
constexpr size_t W_IN = 0, W_OUT = 17 * MiB, W_MQ = 25 * MiB, W_MKV = 33 * MiB, W_MO = 49 * MiB, W_UP = 57 * MiB, W_DOWN = 89 * MiB;
constexpr size_t WS_END = WS_W + 4 * WL;
static_assert(WS_HID + (size_t)M * FF * 2 <= WS_Y, "hid overlay");
constexpr int CW_TMO = 0, CW_BAR = 4096;

constexpr int RING_BYTES = 131072;
constexpr int LDSCTL_OFF = RING_BYTES, MISC_OFF = LDSCTL_OFF + 320;
constexpr int LDS_BYTES = 147456;
constexpr int NWAVES = 8;

__device__ __forceinline__ unsigned cvt_pk_bf16(float lo, float hi) { unsigned r; asm volatile("v_cvt_pk_bf16_f32 %0, %1, %2" : "=v"(r) : "v"(lo), "v"(hi)); return r; }
__device__ __forceinline__ float bf_lo(unsigned w) { return __uint_as_float(w << 16); }
__device__ __forceinline__ float bf_hi(unsigned w) { return __uint_as_float(w & 0xffff0000u); }
__device__ __forceinline__ float wave_sum(float v) {
#pragma unroll
    for (int o = 1; o < 64; o <<= 1) v += __shfl_xor(v, o);
    return v;
}
#define LDS_WAIT() asm volatile("s_waitcnt lgkmcnt(0)" ::: "memory")
#define VM_WAIT() asm volatile("s_waitcnt vmcnt(0)" ::: "memory")
#define WG_BAR() do { asm volatile("" ::: "memory"); __builtin_amdgcn_s_barrier(); asm volatile("" ::: "memory"); } while (0)

namespace pg8 {
constexpr int BM = 256, BK = 64, HALF = 128, HTB = HALF * BK * 2, STAGE_BYTES = 8 * HTB, NXCD = 8, WGM = 8;
__host__ __device__ __forceinline__ int lds_byte(int r, int c) { const int st = (r >> 4) * 2 + (c >> 5), rr = r & 15, cc = c & 31, ob = rr * 64 + cc * 2; return st * 1024 + (ob ^ (((ob >> 9) & 1) << 5)); }
__host__ __device__ __forceinline__ void stage_rc(int b, int& R, int& C) { const int st = b / 1024, sb = b % 1024, swz = sb ^ (((sb >> 9) & 1) << 5); R = (st >> 1) * 16 + swz / 64; C = (st & 1) * 32 + (swz % 64) / 2; }
__host__ __device__ __forceinline__ int perm32(int rho) { const int n = rho >> 4, i = rho & 15; return 8 * (i >> 2) + 4 * n + (i & 3); }

struct Unit { int pm, pn, z; };

__device__ __forceinline__ bool static_order(int i, int G, int c, int nM, int nN, Unit& u) {
    const int nwg = nM * nN; const long L = (long)i * G + c; if (L >= nwg) return false;
    int wgid = (int)L; { const int q = nwg / NXCD, r = nwg % NXCD, xcd = wgid % NXCD, off = wgid / NXCD; wgid = (xcd < r ? xcd * (q + 1) : r * (q + 1) + (xcd - r) * q) + off; }
    const int nig = WGM * nN, gid = wgid / nig, fm = gid * WGM, gsz = (nM - fm) < WGM ? (nM - fm) : WGM;
    u.pm = fm + ((wgid % nig) % gsz); u.pn = (wgid % nig) / gsz; u.z = 0; return true;
}

template <class Epi, class Prob, bool ALIGN_EPI, bool SP2>
__device__ __forceinline__ void gemm_phase(LAS unsigned char* lds, const Prob& S, const Epi& E) {
    int tid_ = threadIdx.x; asm volatile("" : "+v"(tid_));
    const int tid = tid_, wid = __builtin_amdgcn_readfirstlane(tid >> 6), lane = tid & 63, wr = wid >> 2, wc = wid & 3, fr = lane & 15, fq = lane >> 4;
    const int K = S.K, nt = K / BK;
    unsigned voffA[2], voffB[2];
#pragma unroll
    for (int i = 0; i < 2; ++i) { int R, C; stage_rc(tid * 16 + i * 8192, R, C); const int Rb = Epi::PERM ? ((R & ~31) + perm32(R & 31)) : R;
        voffA[i] = (unsigned)(R * S.lda + C) * 2u; voffB[i] = (unsigned)(Rb * S.ldb + C) * 2u; }
    const size_t kstep = (size_t)(BK * 2);
    const size_t hstepA = (size_t)HALF * S.lda * 2, hstepB = (size_t)HALF * S.ldb * 2;
    const unsigned ldsw = (unsigned)wid * 1024u;
    const int aoff = lds_byte(wr * 64 + fr, fq * 8), boff = lds_byte(wc * 32 + fr, fq * 8);
#define PG8_SA(b, h) (((b) * 2 + (h)) * HTB)
#define PG8_SB(b, h) ((4 + (b) * 2 + (h)) * HTB)
#define PG8_STAGE(bufoff, gbase, voff) do { _Pragma("unroll") for (int _i = 0; _i < 2; ++_i) \
        __builtin_amdgcn_global_load_lds((const unsigned*)((const char*)(gbase) + (voff)[_i]), (LAS unsigned*)(lds + (bufoff) + ldsw + _i * 8192), 16, 0, 0); } while (0)
#define PG8_LDA(dst, b, h) do { _Pragma("unroll") for (int m = 0; m < 4; ++m) _Pragma("unroll") for (int k = 0; k < 2; ++k) dst[m][k] = *(const LAS bf16x8*)(lds + PG8_SA(b, h) + aoff + m * 2048 + k * 1024); } while (0)
#define PG8_LDB(dst, b, h) do { _Pragma("unroll") for (int n = 0; n < 2; ++n) _Pragma("unroll") for (int k = 0; k < 2; ++k) dst[n][k] = *(const LAS bf16x8*)(lds + PG8_SB(b, h) + boff + n * 2048 + k * 1024); } while (0)
#define PG8_MMA(ai, bj, At, Bt) do { __builtin_amdgcn_s_setprio(1); _Pragma("unroll") for (int m = 0; m < 4; ++m) _Pragma("unroll") for (int n = 0; n < 2; ++n) _Pragma("unroll") for (int k = 0; k < 2; ++k) \
        acc[ai][bj][m][n] = __builtin_amdgcn_mfma_f32_16x16x32_bf16(Bt[n][k], At[m][k], acc[ai][bj][m][n], 0, 0, 0); __builtin_amdgcn_s_setprio(0); } while (0)
#define PG8_WAIT_V(n) asm volatile("s_waitcnt vmcnt(" #n ")" ::: "memory")
#define PG8_WAIT_L(n) asm volatile("s_waitcnt lgkmcnt(" #n ")" ::: "memory")
#define PG8_BAR __builtin_amdgcn_s_barrier()
#define PG8_SCHED __builtin_amdgcn_sched_barrier(0)
    Unit cur, nxt; int ui = 0;
    if (!S.next(0, cur)) return;
    f32x4 acc[2][2][4][2];
#pragma unroll
    for (int a = 0; a < 2; ++a)
#pragma unroll
        for (int b = 0; b < 2; ++b)
#pragma unroll
            for (int m = 0; m < 4; ++m)
#pragma unroll
                for (int n = 0; n < 2; ++n) acc[a][b][m][n] = (f32x4){0.f, 0.f, 0.f, 0.f};
    bf16x8 At[4][2], B0[2][2], B1[2][2];
    const char* cA = S.aptr(cur); const char* cB = S.bptr(cur);
    if constexpr (SP2) {
        PG8_STAGE(PG8_SB(0, 0), cB, voffB); PG8_STAGE(PG8_SB(0, 1), cB + hstepB, voffB); PG8_STAGE(PG8_SA(0, 0), cA, voffA); PG8_STAGE(PG8_SA(0, 1), cA + hstepA, voffA);
        if (wr == 1) PG8_BAR;
        PG8_WAIT_V(2); PG8_BAR;
        PG8_STAGE(PG8_SB(1, 0), cB + kstep, voffB); PG8_STAGE(PG8_SA(1, 0), cA + kstep, voffA); PG8_STAGE(PG8_SB(1, 1), cB + hstepB + kstep, voffB);
        PG8_WAIT_V(6); PG8_BAR;
    } else {
        PG8_STAGE(PG8_SB(0, 0), cB, voffB); PG8_STAGE(PG8_SA(0, 0), cA, voffA); PG8_STAGE(PG8_SB(0, 1), cB + hstepB, voffB); PG8_STAGE(PG8_SA(0, 1), cA + hstepA, voffA);
        if (wr == 1) PG8_BAR;
        PG8_WAIT_V(4); PG8_BAR;
        PG8_STAGE(PG8_SB(1, 0), cB + kstep, voffB); PG8_STAGE(PG8_SA(1, 0), cA + kstep, voffA); PG8_STAGE(PG8_SB(1, 1), cB + hstepB + kstep, voffB);
        PG8_WAIT_V(6); PG8_BAR;
    }
    for (;;) {
        const bool has_next = S.next(ui + 1, nxt);
        const char* nA = has_next ? S.aptr(nxt) : cA; const char* nB = has_next ? S.bptr(nxt) : cB;
        for (int t = 0; t < nt; t += 2) {
            const bool last = (t == nt - 2);
            const char* a1 = cA + (size_t)(t + 1) * kstep;
            const char* a2 = last ? nA : cA + (size_t)(t + 2) * kstep; const char* b2 = last ? nB : cB + (size_t)(t + 2) * kstep;
            const char* a3 = a2 + kstep; const char* b3 = b2 + kstep;
            if constexpr (SP2) {
            PG8_LDB(B0, 0, 0); PG8_LDB(B1, 0, 1); PG8_SCHED; PG8_LDA(At, 0, 0); PG8_STAGE(PG8_SA(1, 1), a1 + hstepA, voffA);
            PG8_WAIT_V(8); PG8_WAIT_L(0); PG8_BAR; PG8_MMA(0, 0, At, B0); PG8_MMA(0, 1, At, B1); PG8_BAR; PG8_SCHED;
            PG8_LDA(At, 0, 1); PG8_STAGE(PG8_SB(0, 0), b2, voffB); PG8_STAGE(PG8_SB(0, 1), b2 + hstepB, voffB); PG8_STAGE(PG8_SA(0, 0), a2, voffA);
            PG8_WAIT_V(8); PG8_WAIT_L(0); PG8_BAR; PG8_MMA(1, 0, At, B0); PG8_MMA(1, 1, At, B1); PG8_BAR; PG8_SCHED;
            PG8_LDB(B0, 1, 0); PG8_LDB(B1, 1, 1); PG8_SCHED; PG8_LDA(At, 1, 0); PG8_STAGE(PG8_SA(0, 1), a2 + hstepA, voffA);
            PG8_WAIT_V(8); PG8_WAIT_L(0); PG8_BAR; PG8_MMA(0, 0, At, B0); PG8_MMA(0, 1, At, B1); PG8_BAR; PG8_SCHED;
            PG8_LDA(At, 1, 1); PG8_STAGE(PG8_SB(1, 0), b3, voffB); PG8_STAGE(PG8_SB(1, 1), b3 + hstepB, voffB); PG8_STAGE(PG8_SA(1, 0), a3, voffA);
            PG8_WAIT_V(8); PG8_WAIT_L(0); PG8_BAR; PG8_MMA(1, 0, At, B0); PG8_MMA(1, 1, At, B1); PG8_BAR; PG8_SCHED;
            } else {
            PG8_LDB(B0, 0, 0); PG8_SCHED; PG8_LDA(At, 0, 0); PG8_STAGE(PG8_SA(1, 1), a1 + hstepA, voffA);
            PG8_WAIT_L(8); PG8_BAR; PG8_WAIT_L(0); PG8_MMA(0, 0, At, B0); PG8_BAR; PG8_SCHED;
            PG8_LDB(B1, 0, 1); PG8_STAGE(PG8_SB(0, 0), b2, voffB);
            PG8_BAR; PG8_WAIT_L(0); PG8_MMA(0, 1, At, B1); PG8_BAR;
            PG8_LDA(At, 0, 1); PG8_STAGE(PG8_SA(0, 0), a2, voffA);
            PG8_BAR; PG8_WAIT_L(0); PG8_MMA(1, 0, At, B0); PG8_BAR; PG8_SCHED;
            PG8_STAGE(PG8_SB(0, 1), b2 + hstepB, voffB);
            PG8_WAIT_V(6); PG8_BAR; PG8_MMA(1, 1, At, B1); PG8_BAR;
            PG8_LDB(B0, 1, 0); PG8_SCHED; PG8_LDA(At, 1, 0); PG8_STAGE(PG8_SA(0, 1), a2 + hstepA, voffA);
            PG8_WAIT_L(8); PG8_BAR; PG8_WAIT_L(0); PG8_MMA(0, 0, At, B0); PG8_BAR; PG8_SCHED;
            PG8_LDB(B1, 1, 1); PG8_STAGE(PG8_SB(1, 0), b3, voffB);
            PG8_BAR; PG8_WAIT_L(0); PG8_MMA(0, 1, At, B1); PG8_BAR;
            PG8_LDA(At, 1, 1); PG8_STAGE(PG8_SA(1, 0), a3, voffA);
            PG8_BAR; PG8_WAIT_L(0); PG8_MMA(1, 0, At, B0); PG8_BAR; PG8_SCHED;
            PG8_STAGE(PG8_SB(1, 1), b3 + hstepB, voffB);
            PG8_WAIT_V(6); PG8_BAR; PG8_MMA(1, 1, At, B1); PG8_BAR;
            }
        }
        if constexpr (ALIGN_EPI) { if (wr == 0) PG8_BAR; }
        if constexpr (!Epi::AFTER_DRAIN) { E(acc, cur, wr, wc, fr, fq); }
        if (!has_next) break;
#pragma unroll
        for (int a = 0; a < 2; ++a)
#pragma unroll
            for (int b = 0; b < 2; ++b)
#pragma unroll
                for (int m = 0; m < 4; ++m)
#pragma unroll
                    for (int n = 0; n < 2; ++n) acc[a][b][m][n] = (f32x4){0.f, 0.f, 0.f, 0.f};
        cur = nxt; cA = nA; cB = nB; ++ui;
        if constexpr (ALIGN_EPI) { if (wr == 1) PG8_BAR; }
    }
    PG8_WAIT_V(0);
    if constexpr (!ALIGN_EPI) { if (wr == 0) PG8_BAR; }
    PG8_BAR;
    if constexpr (Epi::AFTER_DRAIN) { E.fused(acc, cur, wr, wc, fr, fq, lds, wid, lane); }
#undef PG8_SA
#undef PG8_SB
#undef PG8_STAGE
#undef PG8_LDA
#undef PG8_LDB
#undef PG8_MMA
#undef PG8_WAIT_V
#undef PG8_WAIT_L
#undef PG8_BAR
#undef PG8_SCHED
}

struct ProbMain {
    const bf16_t* A; const bf16_t* Bt; int lda, ldb, K, nM, nN, G, c; size_t bbatch;
    __device__ __forceinline__ bool next(int i, Unit& u) const { return static_order(i, G, c, nM, nN, u); }
    __device__ __forceinline__ const char* aptr(const Unit& u) const { return (const char*)(A + (size_t)u.pm * BM * lda); }
    __device__ __forceinline__ const char* bptr(const Unit& u) const { return (const char*)(Bt + (size_t)(u.pm >> 4) * bbatch + (size_t)u.pn * BM * ldb); }
};
struct ProbKV {
    const bf16_t* A; const bf16_t* W; int lda, ldb, K, G, c;
    __device__ __forceinline__ bool next(int i, Unit& u) const { const int L = i * G + c; if (L >= 128) return false; u.z = L >> 5; u.pm = (L >> 4) & 1; u.pn = L & 15; return true; }
    __device__ __forceinline__ const char* aptr(const Unit& u) const { return (const char*)(A + (size_t)u.pm * BM * lda); }
    __device__ __forceinline__ const char* bptr(const Unit& u) const { return (const char*)W + (size_t)u.z * WL + (size_t)u.pn * BM * ldb * 2; }
};
struct ProbKQ {
    const bf16_t* KV; const unsigned char* Wb; int lda, ldb, K, G, c;
    __device__ __forceinline__ bool next(int i, Unit& u) const { const int L = i * G + c; if (L >= 256) return false; u.z = L >> 3; u.pm = 0; u.pn = L & 7; return true; }
    __device__ __forceinline__ const char* aptr(const Unit& u) const { const int lb = u.z >> 2, h = u.z & 3; return (const char*)(KV + (size_t)lb * 256 * 4096 + h * 512); }
    __device__ __forceinline__ const char* bptr(const Unit& u) const { const int l = u.z >> 3, h = u.z & 3; return (const char*)Wb + (size_t)l * WL + W_MQ + ((size_t)u.pn * BM * 2048 + h * 512) * 2; }
};
struct ProbVO {
    const bf16_t* KV; const unsigned char* Wb; int lda, ldb, K, G, c;
    __device__ __forceinline__ bool next(int i, Unit& u) const { const int L = i * G + c; if (L >= 256) return false; u.z = L >> 3; u.pm = L & 7; u.pn = 0; return true; }
    __device__ __forceinline__ const char* aptr(const Unit& u) const { const int l = u.z >> 3, h = u.z & 3; return (const char*)Wb + (size_t)l * WL + W_MO + ((size_t)u.pm * BM * 2048 + h * 512) * 2; }
    __device__ __forceinline__ const char* bptr(const Unit& u) const { const int lb = u.z >> 2, h = u.z & 3; return (const char*)(KV + (size_t)lb * 256 * 4096 + 2048 + h * 512); }
};

struct EpiPlain {
    static constexpr bool PERM = true, AFTER_DRAIN = false;
    bf16_t* C; int ldc; float scale; int mode;
    __device__ __forceinline__ void operator()(const f32x4 (&acc)[2][2][4][2], const Unit& u, int wr, int wc, int fr, int fq) const {
        size_t toff;
        if (mode == 0) toff = (size_t)u.z * 512 * 4096 + (size_t)u.pm * BM * ldc + (size_t)u.pn * BM;
        else if (mode == 1) toff = (size_t)(u.z >> 2) * 1024 * 2048 + (size_t)(u.z & 3) * 256 * 2048 + (size_t)u.pn * BM;
        else toff = (size_t)(u.z >> 2) * 2048 * 1024 + (size_t)u.pm * BM * 1024 + (size_t)(u.z & 3) * 256;
        bf16_t* base = C + toff + (size_t)(wr * 64 + fr) * ldc + wc * 32 + 8 * fq;
#pragma unroll
        for (int ai = 0; ai < 2; ++ai)
#pragma unroll
            for (int m = 0; m < 4; ++m) { bf16_t* rowp = base + (size_t)(ai * HALF + m * 16) * ldc;
#pragma unroll
                for (int bj = 0; bj < 2; ++bj) { const f32x4 v0 = acc[ai][bj][m][0] * scale, v1 = acc[ai][bj][m][1] * scale;
                    u32x4 w; w.x = cvt_pk_bf16(v0[0], v0[1]); w.y = cvt_pk_bf16(v0[2], v0[3]); w.z = cvt_pk_bf16(v1[0], v1[1]); w.w = cvt_pk_bf16(v1[2], v1[3]);
                    *(u32x4*)(rowp + bj * HALF) = w; } }
    }
};
struct EpiRelu2 {
    static constexpr bool PERM = true, AFTER_DRAIN = false;
    bf16_t* C; int ldc;
    __device__ __forceinline__ void operator()(const f32x4 (&acc)[2][2][4][2], const Unit& u, int wr, int wc, int fr, int fq) const {
        bf16_t* base = C + (size_t)(u.pm * BM + wr * 64 + fr) * ldc + u.pn * BM + wc * 32 + 8 * fq;
#pragma unroll
        for (int ai = 0; ai < 2; ++ai)
#pragma unroll
            for (int m = 0; m < 4; ++m) { bf16_t* rowp = base + (size_t)(ai * HALF + m * 16) * ldc;
#pragma unroll
                for (int bj = 0; bj < 2; ++bj) { f32x4 v0 = acc[ai][bj][m][0], v1 = acc[ai][bj][m][1];
#pragma unroll
                    for (int j = 0; j < 4; ++j) { const float a = fmaxf(v0[j], 0.f), b = fmaxf(v1[j], 0.f); v0[j] = a * a; v1[j] = b * b; }
                    u32x4 w; w.x = cvt_pk_bf16(v0[0], v0[1]); w.y = cvt_pk_bf16(v0[2], v0[3]); w.z = cvt_pk_bf16(v1[0], v1[1]); w.w = cvt_pk_bf16(v1[2], v1[3]);
                    *(u32x4*)(rowp + bj * HALF) = w; } }
    }
};
struct EpiResF32 {
    static constexpr bool PERM = false, AFTER_DRAIN = false;
    const float* X; float* C; int ldc;
    __device__ __forceinline__ void operator()(const f32x4 (&acc)[2][2][4][2], const Unit& u, int wr, int wc, int fr, int fq) const {
        const size_t off0 = (size_t)(u.pm * BM + wr * 64 + fr) * ldc + u.pn * BM + wc * 32 + 4 * fq;
#pragma unroll
        for (int ai = 0; ai < 2; ++ai)
#pragma unroll
            for (int m = 0; m < 4; ++m) { const size_t off = off0 + (size_t)(ai * HALF + m * 16) * ldc;
#pragma unroll
                for (int bj = 0; bj < 2; ++bj)
#pragma unroll
                    for (int n = 0; n < 2; ++n) { const f32x4 xv = *(const f32x4*)(X + off + bj * HALF + n * 16);
                        *(f32x4*)(C + off + bj * HALF + n * 16) = xv * ALPHA + acc[ai][bj][m][n]; } }
    }
};
struct EpiInProj {
    static constexpr bool PERM = true, AFTER_DRAIN = false;
    bf16_t* H; const float* tabA; const float* tabB;
    __device__ __forceinline__ void operator()(const f32x4 (&acc)[2][2][4][2], const Unit& u, int wr, int wc, int fr, int fq) const {
        const int row0 = u.pm * BM + wr * 64 + fr;
#pragma unroll
        for (int bj = 0; bj < 2; ++bj) {
            const int gc = u.pn * BM + bj * HALF;
            const bool ropeA = (gc < VA0) && (wc == 0);
            const bool ropeB = (gc >= QB0) && (gc < VB0) && ((wc & 1) == 0);
            const float sc = (gc < KA0) ? QSA : ((gc >= QB0 && gc < KB0) ? QSB : 1.0f);
#pragma unroll
            for (int ai = 0; ai < 2; ++ai)
#pragma unroll
                for (int m = 0; m < 4; ++m) {
                    const int row = row0 + ai * HALF + m * 16;
                    f32x4 v0 = acc[ai][bj][m][0], v1 = acc[ai][bj][m][1];
                    if (ropeA) {
                        f32x4 p0, p1;
#pragma unroll
                        for (int j = 0; j < 4; ++j) { p0[j] = __shfl_xor(v0[j], 32); p1[j] = __shfl_xor(v1[j], 32); }
                        const float* t = tabA + (size_t)row * 32 + 8 * (fq & 1);
                        const f32x4 c0 = *(const f32x4*)(t), c1 = *(const f32x4*)(t + 4), s0 = *(const f32x4*)(t + 16), s1 = *(const f32x4*)(t + 20);
                        if (fq < 2) { v0 = v0 * c0 - p0 * s0; v1 = v1 * c1 - p1 * s1; } else { v0 = v0 * c0 + p0 * s0; v1 = v1 * c1 + p1 * s1; }
                    }
                    if (ropeB) {
                        f32x4 p0, p1;
#pragma unroll
                        for (int j = 0; j < 4; ++j) { p0[j] = __shfl_xor(v0[j], 16); p1[j] = __shfl_xor(v1[j], 16); }
                        const float* t = tabB + (size_t)row * 16;
                        const f32x4 c0 = *(const f32x4*)(t), c1 = *(const f32x4*)(t + 4), s0 = *(const f32x4*)(t + 8), s1 = *(const f32x4*)(t + 12);
                        if (fq == 0) { v0 = v0 * c0 - p0 * s0; v1 = v1 * c1 - p1 * s1; } else if (fq == 1) { v0 = v0 * c0 + p0 * s0; v1 = v1 * c1 + p1 * s1; }
                    }
                    v0 = v0 * sc; v1 = v1 * sc;
                    u32x4 w; w.x = cvt_pk_bf16(v0[0], v0[1]); w.y = cvt_pk_bf16(v0[2], v0[3]); w.z = cvt_pk_bf16(v1[0], v1[1]); w.w = cvt_pk_bf16(v1[2], v1[3]);
                    *(u32x4*)(H + (size_t)row * INW + gc + wc * 32 + 8 * fq) = w;
                }
        }
    }
};
struct EpiSoftmax {
    static constexpr bool PERM = true, AFTER_DRAIN = true;
    bf16_t* P; int ldc;
    __device__ __forceinline__ void fused(f32x4 (&acc)[2][2][4][2], const Unit& u, int wr, int wc, int fr, int fq, LAS unsigned char* lds, int wid, int lane) const {
        LAS float* Pm = (LAS float*)lds;
        LAS float* Ps = (LAS float*)(lds + 4096);
#pragma unroll
        for (int ai = 0; ai < 2; ++ai)
#pragma unroll
            for (int m = 0; m < 4; ++m) {
                float mx = -INFINITY;
#pragma unroll
                for (int bj = 0; bj < 2; ++bj)
#pragma unroll
                    for (int n = 0; n < 2; ++n)
#pragma unroll
                        for (int j = 0; j < 4; ++j) mx = fmaxf(mx, acc[ai][bj][m][n][j]);
                mx = fmaxf(mx, __shfl_xor(mx, 16)); mx = fmaxf(mx, __shfl_xor(mx, 32));
                if (fq == 0) Pm[(ai * HALF + wr * 64 + m * 16 + fr) * 4 + wc] = mx;
            }
        LDS_WAIT(); WG_BAR();
#pragma unroll
        for (int ai = 0; ai < 2; ++ai)
#pragma unroll
            for (int m = 0; m < 4; ++m) {
                const int r = ai * HALF + wr * 64 + m * 16 + fr;
                const f32x4 q = *(const LAS f32x4*)(Pm + r * 4);
                const float mx = fmaxf(fmaxf(q[0], q[1]), fmaxf(q[2], q[3]));
                float s = 0.f;
#pragma unroll
                for (int bj = 0; bj < 2; ++bj)
#pragma unroll
                    for (int n = 0; n < 2; ++n)
#pragma unroll
                        for (int j = 0; j < 4; ++j) { const float e = __builtin_amdgcn_exp2f(acc[ai][bj][m][n][j] - mx); acc[ai][bj][m][n][j] = e; s += e; }
                s += __shfl_xor(s, 16); s += __shfl_xor(s, 32);
                if (fq == 0) Ps[r * 4 + wc] = s;
            }
        LDS_WAIT(); WG_BAR();
        bf16_t* base = P + (size_t)(u.pm * BM + wr * 64 + fr) * ldc + u.pn * BM + wc * 32 + 8 * fq;
#pragma unroll
        for (int ai = 0; ai < 2; ++ai)
#pragma unroll
            for (int m = 0; m < 4; ++m) {
                const int r = ai * HALF + wr * 64 + m * 16 + fr;
                const f32x4 q = *(const LAS f32x4*)(Ps + r * 4);
                const float inv = 1.0f / ((q[0] + q[1]) + (q[2] + q[3]));
                bf16_t* rowp = base + (size_t)(ai * HALF + m * 16) * ldc;
#pragma unroll
                for (int bj = 0; bj < 2; ++bj) { const f32x4 v0 = acc[ai][bj][m][0] * inv, v1 = acc[ai][bj][m][1] * inv;
                    u32x4 w; w.x = cvt_pk_bf16(v0[0], v0[1]); w.y = cvt_pk_bf16(v0[2], v0[3]); w.z = cvt_pk_bf16(v1[0], v1[1]); w.w = cvt_pk_bf16(v1[2], v1[3]);
                    *(u32x4*)(rowp + bj * HALF) = w; }
            }
        LDS_WAIT(); WG_BAR();
    }
};
}

namespace att {
template <int DH> struct L {
    static constexpr int ROWB = DH * 2, NCH = ROWB / 16, SLOTB = 128 * ROWB, NISS = SLOTB / 8192;
    static __device__ __forceinline__ unsigned swz(unsigned row) { return DH == 128 ? (((row & 3) << 2) | ((row >> 2) & 3)) : (row & 7); }
    static __device__ __forceinline__ unsigned off(unsigned row, unsigned ch) { return ROWB * row + 16 * (ch ^ swz(row)); }
};
template <int DH> __device__ __forceinline__ void dma_block(LAS unsigned char* slot, const bf16_t* g0, size_t gstride, int wid, int lane) {
#pragma unroll
    for (int j = 0; j < L<DH>::NISS; ++j) {
        const unsigned pos = j * 8192 + wid * 1024 + lane * 16, row = pos / L<DH>::ROWB, chs = (pos % L<DH>::ROWB) / 16, ch = chs ^ L<DH>::swz(row);
        const bf16_t* src = g0 + (size_t)row * gstride + ch * 8;
        __builtin_amdgcn_global_load_lds((const unsigned*)src, (LAS unsigned*)(slot + j * 8192 + wid * 1024), 16, 0, 0);
    }
}
template <int DH> __device__ __forceinline__ void zero_block(LAS unsigned char* slot, int wid, int lane) {
#pragma unroll
    for (int j = 0; j < L<DH>::NISS; ++j) *(LAS u32x4*)(slot + j * 8192 + wid * 1024 + lane * 16) = (u32x4){0u, 0u, 0u, 0u};
}
template <int DH> __device__ __forceinline__ void scores(LAS const unsigned char* Kprev, LAS const unsigned char* Kcur, const bf16x8 (&qf)[DH / 32], int w, int g, int i16, bool has_prev, int lo_shift  ,
                                                         bf16x8 (&pk)[5], float& mx_out, float& l_out) {
    f32x4 s[9];
    unsigned laneoff[DH / 32];
#pragma unroll
    for (int ss = 0; ss < DH / 32; ++ss) laneoff[ss] = L<DH>::off(i16, 4 * ss + g);
#pragma unroll
    for (int rt = 0; rt < 9; ++rt) {
        const int kt = w + rt;
        LAS const unsigned char* kb = ((kt < 8) ? Kprev : Kcur) + (kt & 7) * 16 * L<DH>::ROWB;
        f32x4 a = (f32x4){0.f, 0.f, 0.f, 0.f};
#pragma unroll
        for (int ss = 0; ss < DH / 32; ++ss) {
            const bf16x8 kf = *(const LAS bf16x8*)(kb + laneoff[ss]);
            a = __builtin_amdgcn_mfma_f32_16x16x32_bf16(kf, qf[ss], a, 0, 0, 0);
        }
        if (kt < 8 && !has_prev) a = (f32x4){-INFINITY, -INFINITY, -INFINITY, -INFINITY};
        s[rt] = a;
    }
#pragma unroll
    for (int j = 0; j < 4; ++j) { if (4 * g + j < i16 + lo_shift) s[0][j] = -INFINITY; if (4 * g + j > i16) s[8][j] = -INFINITY; }
    float mx = -INFINITY;
#pragma unroll
    for (int rt = 0; rt < 9; ++rt)
#pragma unroll
        for (int j = 0; j < 4; ++j) mx = fmaxf(mx, s[rt][j]);
    mx = fmaxf(mx, __shfl_xor(mx, 16)); mx = fmaxf(mx, __shfl_xor(mx, 32));
    float l = 0.f;
#pragma unroll
    for (int rt = 0; rt < 9; ++rt)
#pragma unroll
        for (int j = 0; j < 4; ++j) { const float e = __builtin_amdgcn_exp2f(s[rt][j] - mx); s[rt][j] = e; l += e; }
    l += __shfl_xor(l, 16); l += __shfl_xor(l, 32);
#pragma unroll
    for (int ck = 0; ck < 5; ++ck) {
        u32x4 wv; wv.x = cvt_pk_bf16(s[2 * ck][0], s[2 * ck][1]); wv.y = cvt_pk_bf16(s[2 * ck][2], s[2 * ck][3]);
        if (ck < 4) { wv.z = cvt_pk_bf16(s[2 * ck + 1][0], s[2 * ck + 1][1]); wv.w = cvt_pk_bf16(s[2 * ck + 1][2], s[2 * ck + 1][3]); } else { wv.z = 0u; wv.w = 0u; }
        pk[ck] = __builtin_bit_cast(bf16x8, wv);
    }
    mx_out = mx; l_out = l;
}
template <int DH> __device__ __forceinline__ void pv(LAS const unsigned char* Vprev, LAS const unsigned char* Vcur, const bf16x8 (&pk)[5], int w, int g, int q4, int p4, f32x4 (&o)[DH / 16]) {
    const unsigned rowl = 4 * g + q4, sw = L<DH>::swz(rowl);
    LAS const unsigned char* vb[10];
#pragma unroll
    for (int rt = 0; rt < 10; ++rt) { const int kt = (w + rt) > 15 ? 15 : (w + rt); vb[rt] = ((kt < 8) ? Vprev : Vcur) + ((kt & 7) * 16 + rowl) * L<DH>::ROWB + 8 * (p4 & 1); }
#pragma unroll
    for (int c = 0; c < DH / 16; ++c) {
        const unsigned coff = 16 * ((2 * c + (p4 >> 1)) ^ sw);
        f32x4 a = (f32x4){0.f, 0.f, 0.f, 0.f};
#pragma unroll
        for (int ck = 0; ck < 5; ++ck) {
            const s16x4 t0 = __builtin_amdgcn_ds_read_tr16_b64_v4i16((LAS s16x4*)(vb[2 * ck] + coff));
            const s16x4 t1 = __builtin_amdgcn_ds_read_tr16_b64_v4i16((LAS s16x4*)(vb[2 * ck + 1] + coff));
            const bf16x8 vf = (bf16x8){t0[0], t0[1], t0[2], t0[3], t1[0], t1[1], t1[2], t1[3]};
            a = __builtin_amdgcn_mfma_f32_16x16x32_bf16(vf, pk[ck], a, 0, 0, 0);
        }
        o[c] = a;
    }
}
}

#define XB_TMO      128
#define XB_XCNT(j)  (256  + 64 * (j))
#define XB_XSUB(j)  (1280 + 64 * (j))
#define XB_XGEN(j)  (2304 + 64 * (j))
#define XB_TOP      3328
#define XB_TOPGEN   3392
#define XCD_BAR_WORDS 3456
#define XB_SPIN_CAP (1u << 18)
__device__ __forceinline__ unsigned xb_ld(unsigned* p)              { return __hip_atomic_load(p, __ATOMIC_RELAXED, __HIP_MEMORY_SCOPE_AGENT); }
__device__ __forceinline__ unsigned xb_add(unsigned* p, unsigned v) { return __hip_atomic_fetch_add(p, v, __ATOMIC_RELAXED, __HIP_MEMORY_SCOPE_AGENT); }
__device__ __forceinline__ unsigned xb_xcc_id() { return (unsigned)__builtin_amdgcn_s_getreg((3 << 11) | 20) & 0xFu; }
#define XB_SPIN(cond, bar) do { unsigned _sp = 0; while (cond) { __builtin_amdgcn_s_sleep(1); \
    if ((++_sp & 255u) == 0u) { if (xb_ld(&(bar)[XB_TMO])) break; if (_sp > XB_SPIN_CAP) { atomicAdd(&(bar)[XB_TMO], 1u); break; } } } } while (0)
struct XcdBarrier { unsigned* bar; unsigned x; volatile LAS unsigned* st; };
__device__ __forceinline__ XcdBarrier xcd_barrier_post(unsigned* bar, volatile LAS unsigned* st) {
    XcdBarrier b; b.bar = bar; b.x = xb_xcc_id(); b.st = st;
    if (threadIdx.x == 0) (void)xb_add(&bar[XB_XCNT(b.x)], 1u);
    return b;
}
__device__ __forceinline__ void xcd_barrier_complete(unsigned* bar, unsigned x, unsigned& nloc, unsigned& nx) {
    const unsigned G = gridDim.x * gridDim.y * gridDim.z;
    unsigned sum, cnt, mine, sp = 0u;
    for (;;) {
        sum = 0u; cnt = 0u; mine = 0u;
#pragma unroll
        for (unsigned j = 0; j < 16; ++j) { const unsigned c = xb_ld(&bar[XB_XCNT(j)]); sum += c; cnt += (c > 0u) ? 1u : 0u; mine = (j == x) ? c : mine; }
        if (sum == G) break;
        __builtin_amdgcn_s_sleep(1);
        if ((++sp & 255u) == 0u) { if (xb_ld(&bar[XB_TMO])) break; if (sp > XB_SPIN_CAP) { atomicAdd(&bar[XB_TMO], 1u); break; } }
    }
    nloc = mine > 0u ? mine : 1u; nx = cnt > 0u ? cnt : 1u;
}
__device__ __forceinline__ void xcd_barrier(const XcdBarrier& b) {
    asm volatile("s_waitcnt vmcnt(0)" ::: "memory");
    __syncthreads();
    if (threadIdx.x == 0) {
        unsigned* bar = b.bar;
        __builtin_amdgcn_s_waitcnt(0);
        unsigned nloc = b.st[0], nx = b.st[1];
        if (nloc == 0u) { xcd_barrier_complete(bar, b.x, nloc, nx); b.st[0] = nloc; b.st[1] = nx; }
        const unsigned old = xb_add(&bar[XB_XSUB(b.x)], 1u);
        const unsigned gen = old / nloc;
        if (old + 1u == (gen + 1u) * nloc) {
            __builtin_amdgcn_fence(__ATOMIC_RELEASE, "agent");
            asm volatile("s_waitcnt vmcnt(0)" ::: "memory");
            const unsigned og = xb_add(&bar[XB_TOP], 1u);
            const unsigned tg = og / nx;
            if (og + 1u == (tg + 1u) * nx) xb_add(&bar[XB_TOPGEN], 1u);
            else XB_SPIN(xb_ld(&bar[XB_TOPGEN]) == tg, bar);
            __builtin_amdgcn_fence(__ATOMIC_ACQUIRE, "agent");
            xb_add(&bar[XB_XGEN(b.x)], 1u);
            asm volatile("s_waitcnt vmcnt(0)" ::: "memory");
        } else {
            XB_SPIN(xb_ld(&bar[XB_XGEN(b.x)]) == gen, bar);
            __builtin_amdgcn_fence(__ATOMIC_ACQUIRE, "agent");
            asm volatile("s_waitcnt vmcnt(0)" ::: "memory");
        }
    }
    __syncthreads();
}

__device__ __forceinline__ unsigned f2bf(float f) { unsigned u = __builtin_bit_cast(unsigned, f); return (u + 0x7fffu + ((u >> 16) & 1u)) >> 16; }
__device__ __forceinline__ unsigned pk2(float lo, float hi) { return f2bf(lo) | (f2bf(hi) << 16); }
__device__ __forceinline__ void transpose_item(const float* W, int K, int N, bf16_t* WT, LAS float* scr, int item, int lane) {
    const int nblk = N / 32, kb = item / nblk, nb = item % nblk, k0 = 64 * kb, n0 = 32 * nb;
#pragma unroll 8
    for (int i = 0; i < 32; ++i) { const int kk = 2 * i + (lane >> 5); scr[kk * 33 + (lane & 31)] = W[(size_t)(k0 + kk) * N + n0 + (lane & 31)]; }
    LDS_WAIT(); asm volatile("" ::: "memory");
    const int c = lane & 7;
#pragma unroll
    for (int j = 0; j < 4; ++j) { const int n = (lane >> 3) + 8 * j; const LAS float* s = scr + (8 * c) * 33 + n;
        u32x4 o; o.x = pk2(s[0 * 33], s[1 * 33]); o.y = pk2(s[2 * 33], s[3 * 33]); o.z = pk2(s[4 * 33], s[5 * 33]); o.w = pk2(s[6 * 33], s[7 * 33]);
        *(u32x4*)(WT + (size_t)(n0 + n) * K + k0 + 8 * c) = o; }
    LDS_WAIT(); asm volatile("" ::: "memory");
}
__device__ __forceinline__ void convert_row2048(const float* src, bf16_t* dst, int lane) {
#pragma unroll
    for (int j = 0; j < 4; ++j) { const f32x4 a = *(const f32x4*)(src + 512 * j + 8 * lane), b = *(const f32x4*)(src + 512 * j + 8 * lane + 4);
        u32x4 o; o.x = pk2(a[0], a[1]); o.y = pk2(a[2], a[3]); o.z = pk2(b[0], b[1]); o.w = pk2(b[2], b[3]);
        *(u32x4*)(dst + 512 * j + 8 * lane) = o; }
}

struct Args { const float* in[19]; float* out; unsigned char* ws; float invA[16]; float invB[8]; int ph_lo, ph_hi; };
constexpr int N_PRO = 4, PPL = 11, N_PHASES = N_PRO + PPL * DEPTH;

__global__ void __launch_bounds__(NWAVES * 64, 2) fwd(Args args) {
    extern __shared__ __attribute__((aligned(16))) unsigned char lds_raw[];
    LAS unsigned char* lds = (LAS unsigned char*)lds_raw;
    volatile LAS unsigned* MISC = (volatile LAS unsigned*)(lds + MISC_OFF);
    const int tid = threadIdx.x, lane = tid & 63, wave = __builtin_amdgcn_readfirstlane(tid >> 6);
    const int G = gridDim.x, bx = blockIdx.x;
    unsigned char* ws = args.ws;
    unsigned* ctl = (unsigned*)(ws + WS_CTL);
    for (int u = tid; u < (LDS_BYTES - LDSCTL_OFF) / 4; u += NWAVES * 64) ((LAS unsigned*)(lds + LDSCTL_OFF))[u] = 0u;
    __syncthreads();
#if MK_PER_PHASE_LAUNCH
#define GRID_BAR() do { } while (0)
#else
    XcdBarrier bar = xcd_barrier_post(ctl + CW_BAR, MISC + 8);
#define GRID_BAR() xcd_barrier(bar)
#endif
    const int lo = args.ph_lo, hi = args.ph_hi;
    int ph = 0;
#define OPAQUE_LANE() int lane_ = threadIdx.x & 63; asm volatile("" : "+v"(lane_)); const int lane = lane_
#ifndef PHASE_MASK
#define PHASE_MASK 0xffffffffu
#endif
    enum { C0 = __COUNTER__ };
#define PH_BEGIN if ((((PHASE_MASK) >> (__COUNTER__ - C0 - 1)) & 1u) && ph >= lo && ph < hi) {
#define PH_END   if (ph + 1 < hi) GRID_BAR(); } ++ph;

    const float* x_in = args.in[0]; const float* mem_in = args.in[1]; const int* pos_in = (const int*)args.in[2];
    float* xf = args.out;
    bf16_t* xb = (bf16_t*)(ws + WS_XB);
    float* pre = (float*)(ws + WS_PRE);
    bf16_t* Hb = (bf16_t*)(ws + WS_H);
    bf16_t* OA = (bf16_t*)(ws + WS_OA);
    bf16_t* OB = (bf16_t*)(ws + WS_OB);
    bf16_t* Yb = (bf16_t*)(ws + WS_Y);
    bf16_t* Pb = (bf16_t*)(ws + WS_P);
    bf16_t* HID = (bf16_t*)(ws + WS_HID);
    bf16_t* KV = (bf16_t*)(ws + WS_KV);
    bf16_t* KQT = (bf16_t*)(ws + WS_KQT);
    bf16_t* VOT = (bf16_t*)(ws + WS_VOT);
    bf16_t* MEMB = (bf16_t*)(ws + WS_MEMB);
    float* tabA = (float*)(ws + WS_TABA); float* tabB = (float*)(ws + WS_TABB);
    float* statM = (float*)(ws + WS_STAT); float* statL = statM + 3 * M * 8;
    const int gw = bx * NWAVES + wave, NGW = G * NWAVES;

    PH_BEGIN
    {
        OPAQUE_LANE();
        LAS float* scr = (LAS float*)(lds + wave * 16384);
        constexpr int I_IN = 32 * 136, I_OUT = 32 * 64, I_MKV = 32 * 128, I_MO = 32 * 64, I_UP = 32 * 256, I_DOWN = 128 * 64, I_MQ = 2048;
        constexpr int I_LAYER = I_IN + I_OUT + I_MKV + I_MO + I_UP + I_DOWN + I_MQ;
        for (int it = gw; it < I_LAYER * DEPTH; it += NGW) {
            const int l = it / I_LAYER; int r = it % I_LAYER;
            unsigned char* wl = ws + WS_W + (size_t)l * WL;
            if (r < I_IN) { transpose_item(args.in[3] + (size_t)l * D * INW, D, INW, (bf16_t*)(wl + W_IN), scr, r, lane); continue; } r -= I_IN;
            if (r < I_OUT) { transpose_item(args.in[7] + (size_t)l * D * D, D, D, (bf16_t*)(wl + W_OUT), scr, r, lane); continue; } r -= I_OUT;
            if (r < I_MKV) { transpose_item(args.in[11] + (size_t)l * D * 2 * D, D, 2 * D, (bf16_t*)(wl + W_MKV), scr, r, lane); continue; } r -= I_MKV;
            if (r < I_MO) { transpose_item(args.in[12] + (size_t)l * D * D, D, D, (bf16_t*)(wl + W_MO), scr, r, lane); continue; } r -= I_MO;
            if (r < I_UP) { transpose_item(args.in[15] + (size_t)l * D * FF, D, FF, (bf16_t*)(wl + W_UP), scr, r, lane); continue; } r -= I_UP;
            if (r < I_DOWN) { transpose_item(args.in[16] + (size_t)l * FF * D, FF, D, (bf16_t*)(wl + W_DOWN), scr, r, lane); continue; } r -= I_DOWN;
            convert_row2048(args.in[10] + (size_t)l * D * D + (size_t)r * D, (bf16_t*)(wl + W_MQ) + (size_t)r * D, lane);
        }
        for (int m = gw; m < M; m += NGW) {
            const float* src = x_in + (size_t)m * D; float* dst = xf + (size_t)m * D;
#pragma unroll
            for (int j = 0; j < 8; ++j) *(f32x4*)(dst + 256 * j + 4 * lane) = *(const f32x4*)(src + 256 * j + 4 * lane);
            convert_row2048(src, xb + (size_t)m * D, lane);
        }
        for (int m = gw; m < NB * NMEM; m += NGW) convert_row2048(mem_in + (size_t)m * D, MEMB + (size_t)m * D, lane);
        for (int e = bx * 512 + wave * 64 + lane; e < M * 24; e += G * 512) {
            const int row = e / 24, i = e % 24;
            const float inv = (i < 16) ? args.invA[i] : args.invB[i - 16];
            const float ang = (float)pos_in[row] * inv;
            double rev = (double)ang * 0.15915494309189535; rev -= floor(rev);
            const float r = (float)rev;
            const float cs = __builtin_amdgcn_cosf(r), sn = __builtin_amdgcn_sinf(r);
            if (i < 16) { tabA[(size_t)row * 32 + i] = cs; tabA[(size_t)row * 32 + 16 + i] = sn; }
            else { tabB[(size_t)row * 16 + (i - 16)] = cs; tabB[(size_t)row * 16 + 8 + (i - 16)] = sn; }
        }
    }
    PH_END

    PH_BEGIN
    {
        pg8::ProbKV S{MEMB, (const bf16_t*)(ws + WS_W + W_MKV), D, D, D, G, bx};
        pg8::EpiPlain E{KV, 4096, 1.0f, 0};
        pg8::gemm_phase<pg8::EpiPlain, pg8::ProbKV, true, true>(lds, S, E);
    }
    PH_END
    PH_BEGIN
    {
        pg8::ProbKQ S{KV, ws + WS_W, 4096, 2048, 512, G, bx};
        pg8::EpiPlain E{KQT, 2048, QSM, 1};
        pg8::gemm_phase<pg8::EpiPlain, pg8::ProbKQ, true, true>(lds, S, E);
    }
    PH_END
    PH_BEGIN
    {
        pg8::ProbVO S{KV, ws + WS_W, 2048, 4096, 512, G, bx};
        pg8::EpiPlain E{VOT, 1024, 1.0f, 2};
        pg8::gemm_phase<pg8::EpiPlain, pg8::ProbVO, true, true>(lds, S, E);
    }
    PH_END

    for (int layer = 0; layer < DEPTH; ++layer) {
        const unsigned char* wl = ws + WS_W + (size_t)layer * WL;
        PH_BEGIN
        {
            pg8::ProbMain S{xb, (const bf16_t*)(wl + W_IN), D, D, D, M / 256, INW / 256, G, bx, 0};
            pg8::EpiInProj E{Hb, tabA, tabB};
            pg8::gemm_phase<pg8::EpiInProj, pg8::ProbMain, true, true>(lds, S, E);
        }
        PH_END
        PH_BEGIN
        {
            OPAQUE_LANE();
            const int g = lane >> 4, i16 = lane & 15, q4 = (lane & 15) >> 2, p4 = lane & 3;
            {
                using LA = att::L<128>;
                LAS unsigned char* Ks = lds; LAS unsigned char* Vs = lds + 2 * LA::SLOTB;
                for (int run = bx; run < 768; run += G) {
                    const int br = run >> 8, rr = run & 255;
                    int dil, chain, n0;
                    if (br == 0) { dil = 16; chain = rr; n0 = 0; }
                    else if (br == 1) { dil = 4; chain = rr >> 2; n0 = 2 * (rr & 3); }
                    else { dil = 1; chain = rr >> 4; n0 = 2 * (rr & 15); }
                    const int h = chain & 7, res = (chain >> 3) % dil, b = (chain >> 3) / dil;
                    const int brslot = (br == 0) ? 2 : (br == 1 ? 1 : 0);
                    const size_t gstride = (size_t)dil * INW;
                    const bf16_t* base = Hb + ((size_t)b * SEQ + res) * INW + h * 128;
                    if (n0 > 0) { att::dma_block<128>(Ks + ((n0 - 1) & 1) * LA::SLOTB, base + KA0 + (size_t)(n0 - 1) * 128 * gstride, gstride, wave, lane);
                                  att::dma_block<128>(Vs + ((n0 - 1) & 1) * LA::SLOTB, base + VA0 + (size_t)(n0 - 1) * 128 * gstride, gstride, wave, lane); }
                    else { att::zero_block<128>(Ks + LA::SLOTB, wave, lane); att::zero_block<128>(Vs + LA::SLOTB, wave, lane); }
                    att::dma_block<128>(Ks + (n0 & 1) * LA::SLOTB, base + KA0 + (size_t)n0 * 128 * gstride, gstride, wave, lane);
                    att::dma_block<128>(Vs + (n0 & 1) * LA::SLOTB, base + VA0 + (size_t)n0 * 128 * gstride, gstride, wave, lane);
                    for (int n = n0; n < n0 + 2; ++n) {
                        const int qi = wave * 16 + i16;
                        const size_t tok = (size_t)b * SEQ + (size_t)(n * 128 + qi) * dil + res;
                        bf16x8 qf[4];
#pragma unroll
                        for (int ss = 0; ss < 4; ++ss) qf[ss] = *(const bf16x8*)(Hb + tok * INW + QA0 + h * 128 + 32 * ss + 8 * g);
                        asm volatile("s_waitcnt vmcnt(0) lgkmcnt(0)" ::: "memory"); WG_BAR();
                        bf16x8 pk[5]; float mx, l;
                        att::scores<128>(Ks + ((n + 1) & 1) * LA::SLOTB, Ks + (n & 1) * LA::SLOTB, qf, wave, g, i16, n > 0, 0, pk, mx, l);
                        WG_BAR();
                        if (n + 1 < n0 + 2) att::dma_block<128>(Ks + ((n + 1) & 1) * LA::SLOTB, base + KA0 + (size_t)(n + 1) * 128 * gstride, gstride, wave, lane);
                        f32x4 o[8];
                        att::pv<128>(Vs + ((n + 1) & 1) * LA::SLOTB, Vs + (n & 1) * LA::SLOTB, pk, wave, g, q4, p4, o);
                        WG_BAR();
                        if (n + 1 < n0 + 2) att::dma_block<128>(Vs + ((n + 1) & 1) * LA::SLOTB, base + VA0 + (size_t)(n + 1) * 128 * gstride, gstride, wave, lane);
                        const float il = 1.0f / l;
                        bf16_t* orow = OA + ((size_t)brslot * M + tok) * 1024 + h * 128 + 4 * g;
#pragma unroll
                        for (int c = 0; c < 8; ++c) { u32x2 w; w.x = cvt_pk_bf16(o[c][0] * il, o[c][1] * il); w.y = cvt_pk_bf16(o[c][2] * il, o[c][3] * il); *(u32x2*)(orow + 16 * c) = w; }
                        if (g == 0) { statM[((size_t)brslot * M + tok) * 8 + h] = mx; statL[((size_t)brslot * M + tok) * 8 + h] = l; }
                    }
                    asm volatile("s_waitcnt vmcnt(0) lgkmcnt(0)" ::: "memory"); WG_BAR();
                }
            }
            {
                using LB = att::L<64>;
                LAS unsigned char* Ks = lds; LAS unsigned char* Vs = lds + 2 * LB::SLOTB;
                const float* sinks = args.in[6] + layer * 16;
                for (int un = bx; un < 256; un += G) {
                    const int b = un >> 7, n = (un >> 2) & 31, kvh = (un >> 1) & 1, quad = un & 1;
                    const bf16_t* base = Hb + (size_t)b * SEQ * INW;
                    if (n > 0) { att::dma_block<64>(Ks + ((n - 1) & 1) * LB::SLOTB, base + KB0 + kvh * 64 + (size_t)(n - 1) * 128 * INW, INW, wave, lane);
                                 att::dma_block<64>(Vs + ((n - 1) & 1) * LB::SLOTB, base + VB0 + kvh * 64 + (size_t)(n - 1) * 128 * INW, INW, wave, lane); }
                    else { att::zero_block<64>(Ks + LB::SLOTB, wave, lane); att::zero_block<64>(Vs + LB::SLOTB, wave, lane); }
                    att::dma_block<64>(Ks + (n & 1) * LB::SLOTB, base + KB0 + kvh * 64 + (size_t)n * 128 * INW, INW, wave, lane);
                    att::dma_block<64>(Vs + (n & 1) * LB::SLOTB, base + VB0 + kvh * 64 + (size_t)n * 128 * INW, INW, wave, lane);
                    asm volatile("s_waitcnt vmcnt(0) lgkmcnt(0)" ::: "memory"); WG_BAR();
                    const int qi = wave * 16 + i16;
                    const size_t tok = (size_t)b * SEQ + n * 128 + qi;
                    for (int qq = 0; qq < 4; ++qq) {
                        const int qh = kvh * 8 + quad * 4 + qq;
                        bf16x8 qf[2];
#pragma unroll
                        for (int ss = 0; ss < 2; ++ss) qf[ss] = *(const bf16x8*)(Hb + tok * INW + QB0 + qh * 64 + 32 * ss + 8 * g);
                        bf16x8 pk[5]; float mx, l;
                        att::scores<64>(Ks + ((n + 1) & 1) * LB::SLOTB, Ks + (n & 1) * LB::SLOTB, qf, wave, g, i16, n > 0, 1, pk, mx, l);
                        f32x4 o[4];
                        att::pv<64>(Vs + ((n + 1) & 1) * LB::SLOTB, Vs + (n & 1) * LB::SLOTB, pk, wave, g, q4, p4, o);
                        const float sk = sinks[qh] * LOG2E, m2 = fmaxf(mx, sk), cc = __builtin_amdgcn_exp2f(mx - m2), den = l * cc + __builtin_amdgcn_exp2f(sk - m2), f = cc / den;
                        bf16_t* orow = OB + tok * 1024 + qh * 64 + 4 * g;
#pragma unroll
                        for (int c = 0; c < 4; ++c) { u32x2 w; w.x = cvt_pk_bf16(o[c][0] * f, o[c][1] * f); w.y = cvt_pk_bf16(o[c][2] * f, o[c][3] * f); *(u32x2*)(orow + 16 * c) = w; }
                    }
                    asm volatile("s_waitcnt vmcnt(0) lgkmcnt(0)" ::: "memory"); WG_BAR();
                }
            }
        }
        PH_END
        PH_BEGIN
        {
            OPAQUE_LANE();
            const float* gna = args.in[4] + layer * 1024; const float* gnb = args.in[5] + layer * 1024;
            for (int m = gw; m < M; m += NGW) {
                const int h = lane >> 3;
                float mm[3], ll[3];
#pragma unroll
                for (int br = 0; br < 3; ++br) { mm[br] = statM[((size_t)br * M + m) * 8 + h]; ll[br] = statL[((size_t)br * M + m) * 8 + h]; }
                const float mxx = fmaxf(mm[0], fmaxf(mm[1], mm[2]));
                float wgt[3]; float den = 0.f;
#pragma unroll
                for (int br = 0; br < 3; ++br) { wgt[br] = ll[br] * __builtin_amdgcn_exp2f(mm[br] - mxx); den += wgt[br]; }
                const float iden = 1.0f / den;
                float ya[16];
#pragma unroll
                for (int k = 0; k < 16; ++k) ya[k] = 0.f;
#pragma unroll
                for (int br = 0; br < 3; ++br) {
                    const u32x4 a = *(const u32x4*)(OA + ((size_t)br * M + m) * 1024 + 16 * lane), b2 = *(const u32x4*)(OA + ((size_t)br * M + m) * 1024 + 16 * lane + 8);
                    const float w = wgt[br] * iden;
                    ya[0] += w * bf_lo(a.x); ya[1] += w * bf_hi(a.x); ya[2] += w * bf_lo(a.y); ya[3] += w * bf_hi(a.y); ya[4] += w * bf_lo(a.z); ya[5] += w * bf_hi(a.z); ya[6] += w * bf_lo(a.w); ya[7] += w * bf_hi(a.w);
                    ya[8] += w * bf_lo(b2.x); ya[9] += w * bf_hi(b2.x); ya[10] += w * bf_lo(b2.y); ya[11] += w * bf_hi(b2.y); ya[12] += w * bf_lo(b2.z); ya[13] += w * bf_hi(b2.z); ya[14] += w * bf_lo(b2.w); ya[15] += w * bf_hi(b2.w);
                }
                float ss = 0.f;
#pragma unroll
                for (int k = 0; k < 16; ++k) ss += ya[k] * ya[k];
                ss = wave_sum(ss);
                const float ra = 1.0f / sqrtf(ss * (1.0f / 1024.0f) + RMS_EPS);
                {
                    const f32x4 g0 = *(const f32x4*)(gna + 16 * lane), g1 = *(const f32x4*)(gna + 16 * lane + 4), g2 = *(const f32x4*)(gna + 16 * lane + 8), g3 = *(const f32x4*)(gna + 16 * lane + 12);
                    u32x4 o0, o1;
                    o0.x = cvt_pk_bf16(ya[0] * ra * g0[0], ya[1] * ra * g0[1]); o0.y = cvt_pk_bf16(ya[2] * ra * g0[2], ya[3] * ra * g0[3]);
                    o0.z = cvt_pk_bf16(ya[4] * ra * g1[0], ya[5] * ra * g1[1]); o0.w = cvt_pk_bf16(ya[6] * ra * g1[2], ya[7] * ra * g1[3]);
                    o1.x = cvt_pk_bf16(ya[8] * ra * g2[0], ya[9] * ra * g2[1]); o1.y = cvt_pk_bf16(ya[10] * ra * g2[2], ya[11] * ra * g2[3]);
                    o1.z = cvt_pk_bf16(ya[12] * ra * g3[0], ya[13] * ra * g3[1]); o1.w = cvt_pk_bf16(ya[14] * ra * g3[2], ya[15] * ra * g3[3]);
                    *(u32x4*)(Yb + (size_t)m * D + 16 * lane) = o0; *(u32x4*)(Yb + (size_t)m * D + 16 * lane + 8) = o1;
                }
                float yb[16];
                {
                    const u32x4 a = *(const u32x4*)(OB + (size_t)m * 1024 + 16 * lane), b2 = *(const u32x4*)(OB + (size_t)m * 1024 + 16 * lane + 8);
                    yb[0] = bf_lo(a.x); yb[1] = bf_hi(a.x); yb[2] = bf_lo(a.y); yb[3] = bf_hi(a.y); yb[4] = bf_lo(a.z); yb[5] = bf_hi(a.z); yb[6] = bf_lo(a.w); yb[7] = bf_hi(a.w);
                    yb[8] = bf_lo(b2.x); yb[9] = bf_hi(b2.x); yb[10] = bf_lo(b2.y); yb[11] = bf_hi(b2.y); yb[12] = bf_lo(b2.z); yb[13] = bf_hi(b2.z); yb[14] = bf_lo(b2.w); yb[15] = bf_hi(b2.w);
                }
                float sb = 0.f;
#pragma unroll
                for (int k = 0; k < 16; ++k) sb += yb[k] * yb[k];
                sb = wave_sum(sb);
                const float rb = 1.0f / sqrtf(sb * (1.0f / 1024.0f) + RMS_EPS);
                {
                    const f32x4 g0 = *(const f32x4*)(gnb + 16 * lane), g1 = *(const f32x4*)(gnb + 16 * lane + 4), g2 = *(const f32x4*)(gnb + 16 * lane + 8), g3 = *(const f32x4*)(gnb + 16 * lane + 12);
                    u32x4 o0, o1;
                    o0.x = cvt_pk_bf16(yb[0] * rb * g0[0], yb[1] * rb * g0[1]); o0.y = cvt_pk_bf16(yb[2] * rb * g0[2], yb[3] * rb * g0[3]);
                    o0.z = cvt_pk_bf16(yb[4] * rb * g1[0], yb[5] * rb * g1[1]); o0.w = cvt_pk_bf16(yb[6] * rb * g1[2], yb[7] * rb * g1[3]);
                    o1.x = cvt_pk_bf16(yb[8] * rb * g2[0], yb[9] * rb * g2[1]); o1.y = cvt_pk_bf16(yb[10] * rb * g2[2], yb[11] * rb * g2[3]);
                    o1.z = cvt_pk_bf16(yb[12] * rb * g3[0], yb[13] * rb * g3[1]); o1.w = cvt_pk_bf16(yb[14] * rb * g3[2], yb[15] * rb * g3[3]);
                    *(u32x4*)(Yb + (size_t)m * D + 1024 + 16 * lane) = o0; *(u32x4*)(Yb + (size_t)m * D + 1024 + 16 * lane + 8) = o1;
                }
            }
        }
        PH_END
#define LN_PHASE(GI, BI) { OPAQUE_LANE(); const float* lg = args.in[GI] + layer * D; const float* lb = args.in[BI] + layer * D; \
            for (int m = gw; m < M; m += NGW) { const float* src = pre + (size_t)m * D; f32x4 v[8]; float s = 0.f; \
                _Pragma("unroll") for (int j = 0; j < 8; ++j) { v[j] = *(const f32x4*)(src + 256 * j + 4 * lane); s += (v[j][0] + v[j][1]) + (v[j][2] + v[j][3]); } \
                const float mean = wave_sum(s) * (1.0f / D); float s2 = 0.f; \
                _Pragma("unroll") for (int j = 0; j < 8; ++j) { v[j] = v[j] - mean; s2 += (v[j][0] * v[j][0] + v[j][1] * v[j][1]) + (v[j][2] * v[j][2] + v[j][3] * v[j][3]); } \
                const float rstd = 1.0f / sqrtf(wave_sum(s2) * (1.0f / D) + LN_EPS); \
                _Pragma("unroll") for (int j = 0; j < 8; ++j) { const f32x4 gg = *(const f32x4*)(lg + 256 * j + 4 * lane), bb = *(const f32x4*)(lb + 256 * j + 4 * lane); \
                    const f32x4 o = v[j] * rstd * gg + bb; *(f32x4*)(xf + (size_t)m * D + 256 * j + 4 * lane) = o; \
                    u32x2 w; w.x = cvt_pk_bf16(o[0], o[1]); w.y = cvt_pk_bf16(o[2], o[3]); *(u32x2*)(xb + (size_t)m * D + 256 * j + 4 * lane) = w; } } }
        PH_BEGIN
        {
            pg8::ProbMain S{Yb, (const bf16_t*)(wl + W_OUT), D, D, D, M / 256, D / 256, G, bx, 0};
            pg8::EpiResF32 E{xf, pre, D};
            pg8::gemm_phase<pg8::EpiResF32, pg8::ProbMain, false, true>(lds, S, E);
        }
        PH_END
        PH_BEGIN
        LN_PHASE(8, 9)
        PH_END
        PH_BEGIN
        {
            pg8::ProbMain S{xb, KQT + (size_t)layer * 2 * 1024 * 2048, D, D, D, M / 256, 1024 / 256, G, bx, (size_t)1024 * 2048};
            pg8::EpiSoftmax E{Pb, 1024};
            pg8::gemm_phase<pg8::EpiSoftmax, pg8::ProbMain, false, true>(lds, S, E);
        }
        PH_END
        PH_BEGIN
        {
            pg8::ProbMain S{Pb, VOT + (size_t)layer * 2 * 2048 * 1024, 1024, 1024, 1024, M / 256, D / 256, G, bx, (size_t)2048 * 1024};
            pg8::EpiResF32 E{xf, pre, D};
            pg8::gemm_phase<pg8::EpiResF32, pg8::ProbMain, false, true>(lds, S, E);
        }
        PH_END
        PH_BEGIN
        LN_PHASE(13, 14)
        PH_END
        PH_BEGIN
        {
            pg8::ProbMain S{xb, (const bf16_t*)(wl + W_UP), D, D, D, M / 256, FF / 256, G, bx, 0};
            pg8::EpiRelu2 E{HID, FF};
            pg8::gemm_phase<pg8::EpiRelu2, pg8::ProbMain, true, true>(lds, S, E);
        }
        PH_END
        PH_BEGIN
        {
            pg8::ProbMain S{HID, (const bf16_t*)(wl + W_DOWN), FF, FF, FF, M / 256, D / 256, G, bx, 0};
            pg8::EpiResF32 E{xf, pre, D};
            pg8::gemm_phase<pg8::EpiResF32, pg8::ProbMain, false, true>(lds, S, E);
        }
        PH_END
        PH_BEGIN
        LN_PHASE(17, 18)
        PH_END
    }
}

extern "C" void kernel_launch(void* const* d_in, const int* in_sizes, int n_in, void* d_out, int out_size, void* d_ws, size_t ws_size, hipStream_t stream) {
    static int grid = 0;
    if (grid == 0) {
        if (n_in != 19 || in_sizes[0] != M * D || out_size != M * D || ws_size < WS_END) { fprintf(stderr, "kernel_launch: unexpected shapes (n_in %d, in0 %d, out %d, ws %zu < %zu); nothing launched\n", n_in, n_in > 0 ? in_sizes[0] : -1, out_size, ws_size, (size_t)WS_END); grid = -1; return; }
        int dev = 0, cus = 0, per_cu = 0;
        if (hipGetDevice(&dev) != hipSuccess || hipDeviceGetAttribute(&cus, hipDeviceAttributeMultiprocessorCount, dev) != hipSuccess) { fprintf(stderr, "kernel_launch: device query failed\n"); grid = -1; return; }
        if (hipFuncSetAttribute((const void*)fwd, hipFuncAttributeMaxDynamicSharedMemorySize, LDS_BYTES) != hipSuccess) { fprintf(stderr, "kernel_launch: hipFuncSetAttribute failed\n"); grid = -1; return; }
        if (hipOccupancyMaxActiveBlocksPerMultiprocessor(&per_cu, (const void*)fwd, NWAVES * 64, LDS_BYTES) != hipSuccess || per_cu < 1) fprintf(stderr, "kernel_launch: note: occupancy query reports %d\n", per_cu);
        (void)hipGetLastError();
        grid = cus;
    }
    if (grid < 0) return;
    if (hipMemsetAsync((char*)d_ws + WS_CTL, 0, CTL_ZERO_BYTES, stream) != hipSuccess) { fprintf(stderr, "kernel_launch: memset failed\n"); return; }
    Args a{};
    for (int i = 0; i < 19; ++i) a.in[i] = (const float*)d_in[i];
    a.out = (float*)d_out; a.ws = (unsigned char*)d_ws;
    for (int i = 0; i < 16; ++i) a.invA[i] = powf(500000.0f, -(float)(2 * i) / 32.0f);
    for (int i = 0; i < 8; ++i) a.invB[i] = powf(500000.0f, -(float)(2 * i) / 16.0f);
#if MK_PER_PHASE_LAUNCH
    for (int p = 0; p < N_PHASES; ++p) { a.ph_lo = p; a.ph_hi = p + 1; hipLaunchKernelGGL(fwd, dim3(grid), dim3(NWAVES * 64), LDS_BYTES, stream, a); }
#else
    a.ph_lo = 0; a.ph_hi = N_PHASES;
    hipLaunchKernelGGL(fwd, dim3(grid), dim3(NWAVES * 64), LDS_BYTES, stream, a);
#endif
    const hipError_t le = hipPeekAtLastError();
    if (le != hipSuccess) fprintf(stderr, "kernel_launch: launch failed: %s\n", hipGetErrorName(le));
}
```

```cpp
#include <hip/hip_runtime.h>
#include <cstdio>
#include <cstdint>
#include <cmath>

#ifndef MK_PER_PHASE_LAUNCH
#define MK_PER_PHASE_LAUNCH 0
#endif

#define LAS __attribute__((address_space(3)))
#define GAS __attribute__((address_space(1)))
typedef unsigned short bf16_t;
typedef short bf16x8 __attribute__((ext_vector_type(8)));
typedef short s16x4 __attribute__((ext_vector_type(4)));
typedef float f32x4 __attribute__((ext_vector_type(4)));
typedef float f32x2 __attribute__((ext_vector_type(2)));
typedef unsigned u32x4 __attribute__((ext_vector_type(4)));
typedef unsigned u32x2 __attribute__((ext_vector_type(2)));
typedef GAS unsigned gu32;

constexpr int D = 2048, NB = 2, SEQ = 4096, M = NB * SEQ, DEPTH = 4, NMEM = 256, FF = 8192;
constexpr int INW = 4352;
constexpr int QA0 = 0, KA0 = 1024, VA0 = 2048, QB0 = 3072, KB0 = 4096, VB0 = 4224;
constexpr float ALPHA = 1.681792830507429f;
constexpr float LN_EPS = 1e-5f, RMS_EPS = 1e-6f;
constexpr float LOG2E = 1.4426950408889634f;
constexpr float QSA = 0.08838834764831845f * LOG2E;
constexpr float QSB = 0.125f * LOG2E;
constexpr float QSM = 0.04419417382415922f * LOG2E;

constexpr size_t MiB = 1u << 20;
constexpr size_t WS_CTL = 0, CTL_ZERO_BYTES = 1 * MiB;
constexpr size_t WS_TABA = 1 * MiB;
constexpr size_t WS_TABB = 2 * MiB;
constexpr size_t WS_MEMB = 3 * MiB;
constexpr size_t WS_STAT = 5 * MiB;
constexpr size_t WS_KV = 8 * MiB;
constexpr size_t WS_KQT = 24 * MiB;
constexpr size_t WS_VOT = 56 * MiB;
constexpr size_t WS_XB = 88 * MiB;
constexpr size_t WS_PRE = 120 * MiB;
constexpr size_t WS_P = 184 * MiB;
constexpr size_t WS_H = 208 * MiB;
constexpr size_t WS_OA = 276 * MiB;
constexpr size_t WS_OB = 324 * MiB;
constexpr size_t WS_Y = 340 * MiB;
constexpr size_t WS_HID = 208 * MiB;
constexpr size_t WS_W = 384 * MiB;
constexpr size_t WL = 121 * MiB;
constexpr size_t W_IN = 0, W_OUT = 17 * MiB, W_MQ = 25 * MiB, W_MKV = 33 * MiB, W_MO = 49 * MiB, W_UP = 57 * MiB, W_DOWN = 89 * MiB;
constexpr size_t WS_END = WS_W + 4 * WL;
static_assert(WS_HID + (size_t)M * FF * 2 <= WS_Y, "hid overlay");
constexpr int CW_TMO = 0, CW_BAR = 4096;

constexpr int RING_BYTES = 131072;
constexpr int LDSCTL_OFF = RING_BYTES, MISC_OFF = LDSCTL_OFF + 320;
constexpr int LDS_BYTES = 147456;
constexpr int NWAVES = 8;

__device__ __forceinline__ unsigned cvt_pk_bf16(float lo, float hi) { unsigned r; asm volatile("v_cvt_pk_bf16_f32 %0, %1, %2" : "=v"(r) : "v"(lo), "v"(hi)); return r; }
__device__ __forceinline__ float bf_lo(unsigned w) { return __uint_as_float(w << 16); }
__device__ __forceinline__ float bf_hi(unsigned w) { return __uint_as_float(w & 0xffff0000u); }
__device__ __forceinline__ float wave_sum(float v) {
#pragma unroll
    for (int o = 1; o < 64; o <<= 1) v += __shfl_xor(v, o);
    return v;
}
#define LDS_WAIT() asm volatile("s_waitcnt lgkmcnt(0)" ::: "memory")
#define VM_WAIT() asm volatile("s_waitcnt vmcnt(0)" ::: "memory")
#define WG_BAR() do { asm volatile("" ::: "memory"); __builtin_amdgcn_s_barrier(); asm volatile("" ::: "memory"); } while (0)

namespace pg8 {
constexpr int BM = 256, BK = 64, HALF = 128, HTB = HALF * BK * 2, STAGE_BYTES = 8 * HTB, NXCD = 8, WGM = 8;
__host__ __device__ __forceinline__ int lds_byte(int r, int c) { const int st = (r >> 4) * 2 + (c >> 5), rr = r & 15, cc = c & 31, ob = rr * 64 + cc * 2; return st * 1024 + (ob ^ (((ob >> 9) & 1) << 5)); }
__host__ __device__ __forceinline__ void stage_rc(int b, int& R, int& C) { const int st = b / 1024, sb = b % 1024, swz = sb ^ (((sb >> 9) & 1) << 5); R = (st >> 1) * 16 + swz / 64; C = (st & 1) * 32 + (swz % 64) / 2; }
__host__ __device__ __forceinline__ int perm32(int rho) { const int n = rho >> 4, i = rho & 15; return 8 * (i >> 2) + 4 * n + (i & 3); }

struct Unit { int pm, pn, z; };

__device__ __forceinline__ bool static_order(int i, int G, int c, int nM, int nN, Unit& u) {
    const int nwg = nM * nN; const long L = (long)i * G + c; if (L >= nwg) return false;
    int wgid = (int)L; { const int q = nwg / NXCD, r = nwg % NXCD, xcd = wgid % NXCD, off = wgid / NXCD; wgid = (xcd < r ? xcd * (q + 1) : r * (q + 1) + (xcd - r) * q) + off; }
    const int nig = WGM * nN, gid = wgid / nig, fm = gid * WGM, gsz = (nM - fm) < WGM ? (nM - fm) : WGM;
    u.pm = fm + ((wgid % nig) % gsz); u.pn = (wgid % nig) / gsz; u.z = 0; return true;
}

template <class Epi, class Prob, bool ALIGN_EPI, bool SP2>
__device__ __forceinline__ void gemm_phase(LAS unsigned char* lds, const Prob& S, const Epi& E) {
    int tid_ = threadIdx.x; asm volatile("" : "+v"(tid_));
    const int tid = tid_, wid = __builtin_amdgcn_readfirstlane(tid >> 6), lane = tid & 63, wr = wid >> 2, wc = wid & 3, fr = lane & 15, fq = lane >> 4;
    const int K = S.K, nt = K / BK;
    unsigned voffA[2], voffB[2];
#pragma unroll
    for (int i = 0; i < 2; ++i) { int R, C; stage_rc(tid * 16 + i * 8192, R, C); const int Rb = Epi::PERM ? ((R & ~31) + perm32(R & 31)) : R;
        voffA[i] = (unsigned)(R * S.lda + C) * 2u; voffB[i] = (unsigned)(Rb * S.ldb + C) * 2u; }
    const size_t kstep = (size_t)(BK * 2);
    const size_t hstepA = (size_t)HALF * S.lda * 2, hstepB = (size_t)HALF * S.ldb * 2;
    const unsigned ldsw = (unsigned)wid * 1024u;
    const int aoff = lds_byte(wr * 64 + fr, fq * 8), boff = lds_byte(wc * 32 + fr, fq * 8);
#define PG8_SA(b, h) (((b) * 2 + (h)) * HTB)
#define PG8_SB(b, h) ((4 + (b) * 2 + (h)) * HTB)
#define PG8_STAGE(bufoff, gbase, voff) do { _Pragma("unroll") for (int _i = 0; _i < 2; ++_i) \
        __builtin_amdgcn_global_load_lds((const unsigned*)((const char*)(gbase) + (voff)[_i]), (LAS unsigned*)(lds + (bufoff) + ldsw + _i * 8192), 16, 0, 0); } while (0)
#define PG8_LDA(dst, b, h) do { _Pragma("unroll") for (int m = 0; m < 4; ++m) _Pragma("unroll") for (int k = 0; k < 2; ++k) dst[m][k] = *(const LAS bf16x8*)(lds + PG8_SA(b, h) + aoff + m * 2048 + k * 1024); } while (0)
#define PG8_LDB(dst, b, h) do { _Pragma("unroll") for (int n = 0; n < 2; ++n) _Pragma("unroll") for (int k = 0; k < 2; ++k) dst[n][k] = *(const LAS bf16x8*)(lds + PG8_SB(b, h) + boff + n * 2048 + k * 1024); } while (0)
#define PG8_MMA(ai, bj, At, Bt) do { __builtin_amdgcn_s_setprio(1); _Pragma("unroll") for (int m = 0; m < 4; ++m) _Pragma("unroll") for (int n = 0; n < 2; ++n) _Pragma("unroll") for (int k = 0; k < 2; ++k) \
        acc[ai][bj][m][n] = __builtin_amdgcn_mfma_f32_16x16x32_bf16(Bt[n][k], At[m][k], acc[ai][bj][m][n], 0, 0, 0); __builtin_amdgcn_s_setprio(0); } while (0)
#define PG8_WAIT_V(n) asm volatile("s_waitcnt vmcnt(" #n ")" ::: "memory")
#define PG8_WAIT_L(n) asm volatile("s_waitcnt lgkmcnt(" #n ")" ::: "memory")
#define PG8_BAR __builtin_amdgcn_s_barrier()
#define PG8_SCHED __builtin_amdgcn_sched_barrier(0)
    Unit cur, nxt; int ui = 0;
    if (!S.next(0, cur)) return;
    f32x4 acc[2][2][4][2];
#pragma unroll
    for (int a = 0; a < 2; ++a)
#pragma unroll
        for (int b = 0; b < 2; ++b)
#pragma unroll
            for (int m = 0; m < 4; ++m)
#pragma unroll
                for (int n = 0; n < 2; ++n) acc[a][b][m][n] = (f32x4){0.f, 0.f, 0.f, 0.f};
    bf16x8 At[4][2], B0[2][2], B1[2][2];
    const char* cA = S.aptr(cur); const char* cB = S.bptr(cur);
    if constexpr (SP2) {
        PG8_STAGE(PG8_SB(0, 0), cB, voffB); PG8_STAGE(PG8_SB(0, 1), cB + hstepB, voffB); PG8_STAGE(PG8_SA(0, 0), cA, voffA); PG8_STAGE(PG8_SA(0, 1), cA + hstepA, voffA);
        if (wr == 1) PG8_BAR;
        PG8_WAIT_V(2); PG8_BAR;
        PG8_STAGE(PG8_SB(1, 0), cB + kstep, voffB); PG8_STAGE(PG8_SA(1, 0), cA + kstep, voffA); PG8_STAGE(PG8_SB(1, 1), cB + hstepB + kstep, voffB);
        PG8_WAIT_V(6); PG8_BAR;
    } else {
        PG8_STAGE(PG8_SB(0, 0), cB, voffB); PG8_STAGE(PG8_SA(0, 0), cA, voffA); PG8_STAGE(PG8_SB(0, 1), cB + hstepB, voffB); PG8_STAGE(PG8_SA(0, 1), cA + hstepA, voffA);
        if (wr == 1) PG8_BAR;
        PG8_WAIT_V(4); PG8_BAR;
        PG8_STAGE(PG8_SB(1, 0), cB + kstep, voffB); PG8_STAGE(PG8_SA(1, 0), cA + kstep, voffA); PG8_STAGE(PG8_SB(1, 1), cB + hstepB + kstep, voffB);
        PG8_WAIT_V(6); PG8_BAR;
    }
    for (;;) {
        const bool has_next = S.next(ui + 1, nxt);
        const char* nA = has_next ? S.aptr(nxt) : cA; const char* nB = has_next ? S.bptr(nxt) : cB;
        for (int t = 0; t < nt; t += 2) {
            const bool last = (t == nt - 2);
            const char* a1 = cA + (size_t)(t + 1) * kstep;
            const char* a2 = last ? nA : cA + (size_t)(t + 2) * kstep; const char* b2 = last ? nB : cB + (size_t)(t + 2) * kstep;
            const char* a3 = a2 + kstep; const char* b3 = b2 + kstep;
            if constexpr (SP2) {
            PG8_LDB(B0, 0, 0); PG8_LDB(B1, 0, 1); PG8_SCHED; PG8_LDA(At, 0, 0); PG8_STAGE(PG8_SA(1, 1), a1 + hstepA, voffA);
            PG8_WAIT_V(8); PG8_WAIT_L(0); PG8_BAR; PG8_MMA(0, 0, At, B0); PG8_MMA(0, 1, At, B1); PG8_BAR; PG8_SCHED;
            PG8_LDA(At, 0, 1); PG8_STAGE(PG8_SB(0, 0), b2, voffB); PG8_STAGE(PG8_SB(0, 1), b2 + hstepB, voffB); PG8_STAGE(PG8_SA(0, 0), a2, voffA);
            PG8_WAIT_V(8); PG8_WAIT_L(0); PG8_BAR; PG8_MMA(1, 0, At, B0); PG8_MMA(1, 1, At, B1); PG8_BAR; PG8_SCHED;
            PG8_LDB(B0, 1, 0); PG8_LDB(B1, 1, 1); PG8_SCHED; PG8_LDA(At, 1, 0); PG8_STAGE(PG8_SA(0, 1), a2 + hstepA, voffA);
            PG8_WAIT_V(8); PG8_WAIT_L(0); PG8_BAR; PG8_MMA(0, 0, At, B0); PG8_MMA(0, 1, At, B1); PG8_BAR; PG8_SCHED;
            PG8_LDA(At, 1, 1); PG8_STAGE(PG8_SB(1, 0), b3, voffB); PG8_STAGE(PG8_SB(1, 1), b3 + hstepB, voffB); PG8_STAGE(PG8_SA(1, 0), a3, voffA);
            PG8_WAIT_V(8); PG8_WAIT_L(0); PG8_BAR; PG8_MMA(1, 0, At, B0); PG8_MMA(1, 1, At, B1); PG8_BAR; PG8_SCHED;
            } else {
            PG8_LDB(B0, 0, 0); PG8_SCHED; PG8_LDA(At, 0, 0); PG8_STAGE(PG8_SA(1, 1), a1 + hstepA, voffA);
            PG8_WAIT_L(8); PG8_BAR; PG8_WAIT_L(0); PG8_MMA(0, 0, At, B0); PG8_BAR; PG8_SCHED;
            PG8_LDB(B1, 0, 1); PG8_STAGE(PG8_SB(0, 0), b2, voffB);
            PG8_BAR; PG8_WAIT_L(0); PG8_MMA(0, 1, At, B1); PG8_BAR;
            PG8_LDA(At, 0, 1); PG8_STAGE(PG8_SA(0, 0), a2, voffA);
            PG8_BAR; PG8_WAIT_L(0); PG8_MMA(1, 0, At, B0); PG8_BAR; PG8_SCHED;
            PG8_STAGE(PG8_SB(0, 1), b2 + hstepB, voffB);
            PG8_WAIT_V(6); PG8_BAR; PG8_MMA(1, 1, At, B1); PG8_BAR;
            PG8_LDB(B0, 1, 0); PG8_SCHED; PG8_LDA(At, 1, 0); PG8_STAGE(PG8_SA(0, 1), a2 + hstepA, voffA);
            PG8_WAIT_L(8); PG8_BAR; PG8_WAIT_L(0); PG8_MMA(0, 0, At, B0); PG8_BAR; PG8_SCHED;
            PG8_LDB(B1, 1, 1); PG8_STAGE(PG8_SB(1, 0), b3, voffB);
            PG8_BAR; PG8_WAIT_L(0); PG8_MMA(0, 1, At, B1); PG8_BAR;
            PG8_LDA(At, 1, 1); PG8_STAGE(PG8_SA(1, 0), a3, voffA);
            PG8_BAR; PG8_WAIT_L(0); PG8_MMA(1, 0, At, B0); PG8_BAR; PG8_SCHED;
            PG8_STAGE(PG8_SB(1, 1), b3 + hstepB, voffB);
            PG8_WAIT_V(6); PG8_BAR; PG8_MMA(1, 1, At, B1); PG8_BAR;
            }
        }
        if constexpr (ALIGN_EPI) { if (wr == 0) PG8_BAR; }
        if constexpr (!Epi::AFTER_DRAIN) { E(acc, cur, wr, wc, fr, fq); }
        if (!has_next) break;
#pragma unroll
        for (int a = 0; a < 2; ++a)
#pragma unroll
            for (int b = 0; b < 2; ++b)
#pragma unroll
                for (int m = 0; m < 4; ++m)
#pragma unroll
                    for (int n = 0; n < 2; ++n) acc[a][b][m][n] = (f32x4){0.f, 0.f, 0.f, 0.f};
        cur = nxt; cA = nA; cB = nB; ++ui;
        if constexpr (ALIGN_EPI) { if (wr == 1) PG8_BAR; }
    }
    PG8_WAIT_V(0);
    if constexpr (!ALIGN_EPI) { if (wr == 0) PG8_BAR; }
    PG8_BAR;
    if constexpr (Epi::AFTER_DRAIN) { E.fused(acc, cur, wr, wc, fr, fq, lds, wid, lane); }
#undef PG8_SA
#undef PG8_SB
#undef PG8_STAGE
#undef PG8_LDA
#undef PG8_LDB
#undef PG8_MMA
#undef PG8_WAIT_V
#undef PG8_WAIT_L
#undef PG8_BAR
#undef PG8_SCHED
}

struct ProbMain {
    const bf16_t* A; const bf16_t* Bt; int lda, ldb, K, nM, nN, G, c; size_t bbatch;
    __device__ __forceinline__ bool next(int i, Unit& u) const { return static_order(i, G, c, nM, nN, u); }
    __device__ __forceinline__ const char* aptr(const Unit& u) const { return (const char*)(A + (size_t)u.pm * BM * lda); }
    __device__ __forceinline__ const char* bptr(const Unit& u) const { return (const char*)(Bt + (size_t)(u.pm >> 4) * bbatch + (size_t)u.pn * BM * ldb); }
};
struct ProbKV {
    const bf16_t* A; const bf16_t* W; int lda, ldb, K, G, c;
    __device__ __forceinline__ bool next(int i, Unit& u) const { const int L = i * G + c; if (L >= 128) return false; u.z = L >> 5; u.pm = (L >> 4) & 1; u.pn = L & 15; return true; }
    __device__ __forceinline__ const char* aptr(const Unit& u) const { return (const char*)(A + (size_t)u.pm * BM * lda); }
    __device__ __forceinline__ const char* bptr(const Unit& u) const { return (const char*)W + (size_t)u.z * WL + (size_t)u.pn * BM * ldb * 2; }
};
struct ProbKQ {
    const bf16_t* KV; const unsigned char* Wb; int lda, ldb, K, G, c;
    __device__ __forceinline__ bool next(int i, Unit& u) const { const int L = i * G + c; if (L >= 256) return false; u.z = L >> 3; u.pm = 0; u.pn = L & 7; return true; }
    __device__ __forceinline__ const char* aptr(const Unit& u) const { const int lb = u.z >> 2, h = u.z & 3; return (const char*)(KV + (size_t)lb * 256 * 4096 + h * 512); }
    __device__ __forceinline__ const char* bptr(const Unit& u) const { const int l = u.z >> 3, h = u.z & 3; return (const char*)Wb + (size_t)l * WL + W_MQ + ((size_t)u.pn * BM * 2048 + h * 512) * 2; }
};
struct ProbVO {
    const bf16_t* KV; const unsigned char* Wb; int lda, ldb, K, G, c;
    __device__ __forceinline__ bool next(int i, Unit& u) const { const int L = i * G + c; if (L >= 256) return false; u.z = L >> 3; u.pm = L & 7; u.pn = 0; return true; }
    __device__ __forceinline__ const char* aptr(const Unit& u) const { const int l = u.z >> 3, h = u.z & 3; return (const char*)Wb + (size_t)l * WL + W_MO + ((size_t)u.pm * BM * 2048 + h * 512) * 2; }
    __device__ __forceinline__ const char* bptr(const Unit& u) const { const int lb = u.z >> 2, h = u.z & 3; return (const char*)(KV + (size_t)lb * 256 * 4096 + 2048 + h * 512); }
};

struct EpiPlain {
    static constexpr bool PERM = true, AFTER_DRAIN = false;
    bf16_t* C; int ldc; float scale; int mode;
    __device__ __forceinline__ void operator()(const f32x4 (&acc)[2][2][4][2], const Unit& u, int wr, int wc, int fr, int fq) const {
        size_t toff;
        if (mode == 0) toff = (size_t)u.z * 512 * 4096 + (size_t)u.pm * BM * ldc + (size_t)u.pn * BM;
        else if (mode == 1) toff = (size_t)(u.z >> 2) * 1024 * 2048 + (size_t)(u.z & 3) * 256 * 2048 + (size_t)u.pn * BM;
        else toff = (size_t)(u.z >> 2) * 2048 * 1024 + (size_t)u.pm * BM * 1024 + (size_t)(u.z & 3) * 256;
        bf16_t* base = C + toff + (size_t)(wr * 64 + fr) * ldc + wc * 32 + 8 * fq;
#pragma unroll
        for (int ai = 0; ai < 2; ++ai)
#pragma unroll
            for (int m = 0; m < 4; ++m) { bf16_t* rowp = base + (size_t)(ai * HALF + m * 16) * ldc;
#pragma unroll
                for (int bj = 0; bj < 2; ++bj) { const f32x4 v0 = acc[ai][bj][m][0] * scale, v1 = acc[ai][bj][m][1] * scale;
                    u32x4 w; w.x = cvt_pk_bf16(v0[0], v0[1]); w.y = cvt_pk_bf16(v0[2], v0[3]); w.z = cvt_pk_bf16(v1[0], v1[1]); w.w = cvt_pk_bf16(v1[2], v1[3]);
                    *(u32x4*)(rowp + bj * HALF) = w; } }
    }
};
struct EpiRelu2 {
    static constexpr bool PERM = true, AFTER_DRAIN = false;
    bf16_t* C; int ldc;
    __device__ __forceinline__ void operator()(const f32x4 (&acc)[2][2][4][2], const Unit& u, int wr, int wc, int fr, int fq) const {
        bf16_t* base = C + (size_t)(u.pm * BM + wr * 64 + fr) * ldc + u.pn * BM + wc * 32 + 8 * fq;
#pragma unroll
        for (int ai = 0; ai < 2; ++ai)
#pragma unroll
            for (int m = 0; m < 4; ++m) { bf16_t* rowp = base + (size_t)(ai * HALF + m * 16) * ldc;
#pragma unroll
                for (int bj = 0; bj < 2; ++bj) { f32x4 v0 = acc[ai][bj][m][0], v1 = acc[ai][bj][m][1];
#pragma unroll
                    for (int j = 0; j < 4; ++j) { const float a = fmaxf(v0[j], 0.f), b = fmaxf(v1[j], 0.f); v0[j] = a * a; v1[j] = b * b; }
                    u32x4 w; w.x = cvt_pk_bf16(v0[0], v0[1]); w.y = cvt_pk_bf16(v0[2], v0[3]); w.z = cvt_pk_bf16(v1[0], v1[1]); w.w = cvt_pk_bf16(v1[2], v1[3]);
                    *(u32x4*)(rowp + bj * HALF) = w; } }
    }
};
struct EpiResF32 {
    static constexpr bool PERM = false, AFTER_DRAIN = false;
    const float* X; float* C; int ldc;
    __device__ __forceinline__ void operator()(const f32x4 (&acc)[2][2][4][2], const Unit& u, int wr, int wc, int fr, int fq) const {
        const size_t off0 = (size_t)(u.pm * BM + wr * 64 + fr) * ldc + u.pn * BM + wc * 32 + 4 * fq;
#pragma unroll
        for (int ai = 0; ai < 2; ++ai)
#pragma unroll
            for (int m = 0; m < 4; ++m) { const size_t off = off0 + (size_t)(ai * HALF + m * 16) * ldc;
#pragma unroll
                for (int bj = 0; bj < 2; ++bj)
#pragma unroll
                    for (int n = 0; n < 2; ++n) { const f32x4 xv = *(const f32x4*)(X + off + bj * HALF + n * 16);
                        *(f32x4*)(C + off + bj * HALF + n * 16) = xv * ALPHA + acc[ai][bj][m][n]; } }
    }
};
struct EpiInProj {
    static constexpr bool PERM = true, AFTER_DRAIN = false;
    bf16_t* H; const float* tabA; const float* tabB;
    __device__ __forceinline__ void operator()(const f32x4 (&acc)[2][2][4][2], const Unit& u, int wr, int wc, int fr, int fq) const {
        const int row0 = u.pm * BM + wr * 64 + fr;
#pragma unroll
        for (int bj = 0; bj < 2; ++bj) {
            const int gc = u.pn * BM + bj * HALF;
            const bool ropeA = (gc < VA0) && (wc == 0);
            const bool ropeB = (gc >= QB0) && (gc < VB0) && ((wc & 1) == 0);
            const float sc = (gc < KA0) ? QSA : ((gc >= QB0 && gc < KB0) ? QSB : 1.0f);
#pragma unroll
            for (int ai = 0; ai < 2; ++ai)
#pragma unroll
                for (int m = 0; m < 4; ++m) {
                    const int row = row0 + ai * HALF + m * 16;
                    f32x4 v0 = acc[ai][bj][m][0], v1 = acc[ai][bj][m][1];
                    if (ropeA) {
                        f32x4 p0, p1;
#pragma unroll
                        for (int j = 0; j < 4; ++j) { p0[j] = __shfl_xor(v0[j], 32); p1[j] = __shfl_xor(v1[j], 32); }
                        const float* t = tabA + (size_t)row * 32 + 8 * (fq & 1);
                        const f32x4 c0 = *(const f32x4*)(t), c1 = *(const f32x4*)(t + 4), s0 = *(const f32x4*)(t + 16), s1 = *(const f32x4*)(t + 20);
                        if (fq < 2) { v0 = v0 * c0 - p0 * s0; v1 = v1 * c1 - p1 * s1; } else { v0 = v0 * c0 + p0 * s0; v1 = v1 * c1 + p1 * s1; }
                    }
                    if (ropeB) {
                        f32x4 p0, p1;
#pragma unroll
                        for (int j = 0; j < 4; ++j) { p0[j] = __shfl_xor(v0[j], 16); p1[j] = __shfl_xor(v1[j], 16); }
                        const float* t = tabB + (size_t)row * 16;
                        const f32x4 c0 = *(const f32x4*)(t), c1 = *(const f32x4*)(t + 4), s0 = *(const f32x4*)(t + 8), s1 = *(const f32x4*)(t + 12);
                        if (fq == 0) { v0 = v0 * c0 - p0 * s0; v1 = v1 * c1 - p1 * s1; } else if (fq == 1) { v0 = v0 * c0 + p0 * s0; v1 = v1 * c1 + p1 * s1; }
                    }
                    v0 = v0 * sc; v1 = v1 * sc;
                    u32x4 w; w.x = cvt_pk_bf16(v0[0], v0[1]); w.y = cvt_pk_bf16(v0[2], v0[3]); w.z = cvt_pk_bf16(v1[0], v1[1]); w.w = cvt_pk_bf16(v1[2], v1[3]);
                    *(u32x4*)(H + (size_t)row * INW + gc + wc * 32 + 8 * fq) = w;
                }
        }
    }
};
struct EpiSoftmax {
    static constexpr bool PERM = true, AFTER_DRAIN = true;
    bf16_t* P; int ldc;
    __device__ __forceinline__ void fused(f32x4 (&acc)[2][2][4][2], const Unit& u, int wr, int wc, int fr, int fq, LAS unsigned char* lds, int wid, int lane) const {
        LAS float* Pm = (LAS float*)lds;
        LAS float* Ps = (LAS float*)(lds + 4096);
#pragma unroll
        for (int ai = 0; ai < 2; ++ai)
#pragma unroll
            for (int m = 0; m < 4; ++m) {
                float mx = -INFINITY;
#pragma unroll
                for (int bj = 0; bj < 2; ++bj)
#pragma unroll
                    for (int n = 0; n < 2; ++n)
#pragma unroll
                        for (int j = 0; j < 4; ++j) mx = fmaxf(mx, acc[ai][bj][m][n][j]);
                mx = fmaxf(mx, __shfl_xor(mx, 16)); mx = fmaxf(mx, __shfl_xor(mx, 32));
                if (fq == 0) Pm[(ai * HALF + wr * 64 + m * 16 + fr) * 4 + wc] = mx;
            }
        LDS_WAIT(); WG_BAR();
#pragma unroll
        for (int ai = 0; ai < 2; ++ai)
#pragma unroll
            for (int m = 0; m < 4; ++m) {
                const int r = ai * HALF + wr * 64 + m * 16 + fr;
                const f32x4 q = *(const LAS f32x4*)(Pm + r * 4);
                const float mx = fmaxf(fmaxf(q[0], q[1]), fmaxf(q[2], q[3]));
                float s = 0.f;
#pragma unroll
                for (int bj = 0; bj < 2; ++bj)
#pragma unroll
                    for (int n = 0; n < 2; ++n)
#pragma unroll
                        for (int j = 0; j < 4; ++j) { const float e = __builtin_amdgcn_exp2f(acc[ai][bj][m][n][j] - mx); acc[ai][bj][m][n][j] = e; s += e; }
                s += __shfl_xor(s, 16); s += __shfl_xor(s, 32);
                if (fq == 0) Ps[r * 4 + wc] = s;
            }
        LDS_WAIT(); WG_BAR();
        bf16_t* base = P + (size_t)(u.pm * BM + wr * 64 + fr) * ldc + u.pn * BM + wc * 32 + 8 * fq;
#pragma unroll
        for (int ai = 0; ai < 2; ++ai)
#pragma unroll
            for (int m = 0; m < 4; ++m) {
                const int r = ai * HALF + wr * 64 + m * 16 + fr;
                const f32x4 q = *(const LAS f32x4*)(Ps + r * 4);
                const float inv = 1.0f / ((q[0] + q[1]) + (q[2] + q[3]));
                bf16_t* rowp = base + (size_t)(ai * HALF + m * 16) * ldc;
#pragma unroll
                for (int bj = 0; bj < 2; ++bj) { const f32x4 v0 = acc[ai][bj][m][0] * inv, v1 = acc[ai][bj][m][1] * inv;
                    u32x4 w; w.x = cvt_pk_bf16(v0[0], v0[1]); w.y = cvt_pk_bf16(v0[2], v0[3]); w.z = cvt_pk_bf16(v1[0], v1[1]); w.w = cvt_pk_bf16(v1[2], v1[3]);
                    *(u32x4*)(rowp + bj * HALF) = w; }
            }
        LDS_WAIT(); WG_BAR();
    }
};
}

namespace att {
template <int DH> struct L {
    static constexpr int ROWB = DH * 2, NCH = ROWB / 16, SLOTB = 128 * ROWB, NISS = SLOTB / 8192;
    static __device__ __forceinline__ unsigned swz(unsigned row) { return DH == 128 ? (((row & 3) << 2) | ((row >> 2) & 3)) : (row & 7); }
    static __device__ __forceinline__ unsigned off(unsigned row, unsigned ch) { return ROWB * row + 16 * (ch ^ swz(row)); }
};
template <int DH> __device__ __forceinline__ void dma_block(LAS unsigned char* slot, const bf16_t* g0, size_t gstride, int wid, int lane) {
#pragma unroll
    for (int j = 0; j < L<DH>::NISS; ++j) {
        const unsigned pos = j * 8192 + wid * 1024 + lane * 16, row = pos / L<DH>::ROWB, chs = (pos % L<DH>::ROWB) / 16, ch = chs ^ L<DH>::swz(row);
        const bf16_t* src = g0 + (size_t)row * gstride + ch * 8;
        __builtin_amdgcn_global_load_lds((const unsigned*)src, (LAS unsigned*)(slot + j * 8192 + wid * 1024), 16, 0, 0);
    }
}
template <int DH> __device__ __forceinline__ void zero_block(LAS unsigned char* slot, int wid, int lane) {
#pragma unroll
    for (int j = 0; j < L<DH>::NISS; ++j) *(LAS u32x4*)(slot + j * 8192 + wid * 1024 + lane * 16) = (u32x4){0u, 0u, 0u, 0u};
}
template <int DH> __device__ __forceinline__ void scores(LAS const unsigned char* Kprev, LAS const unsigned char* Kcur, const bf16x8 (&qf)[DH / 32], int w, int g, int i16, bool has_prev, int lo_shift  ,
                                                         bf16x8 (&pk)[5], float& mx_out, float& l_out) {
    f32x4 s[9];
    unsigned laneoff[DH / 32];
#pragma unroll
    for (int ss = 0; ss < DH / 32; ++ss) laneoff[ss] = L<DH>::off(i16, 4 * ss + g);
#pragma unroll
    for (int rt = 0; rt < 9; ++rt) {
        const int kt = w + rt;
        LAS const unsigned char* kb = ((kt < 8) ? Kprev : Kcur) + (kt & 7) * 16 * L<DH>::ROWB;
        f32x4 a = (f32x4){0.f, 0.f, 0.f, 0.f};
#pragma unroll
        for (int ss = 0; ss < DH / 32; ++ss) {
            const bf16x8 kf = *(const LAS bf16x8*)(kb + laneoff[ss]);
            a = __builtin_amdgcn_mfma_f32_16x16x32_bf16(kf, qf[ss], a, 0, 0, 0);
        }
        if (kt < 8 && !has_prev) a = (f32x4){-INFINITY, -INFINITY, -INFINITY, -INFINITY};
        s[rt] = a;
    }
#pragma unroll
    for (int j = 0; j < 4; ++j) { if (4 * g + j < i16 + lo_shift) s[0][j] = -INFINITY; if (4 * g + j > i16) s[8][j] = -INFINITY; }
    float mx = -INFINITY;
#pragma unroll
    for (int rt = 0; rt < 9; ++rt)
#pragma unroll
        for (int j = 0; j < 4; ++j) mx = fmaxf(mx, s[rt][j]);
    mx = fmaxf(mx, __shfl_xor(mx, 16)); mx = fmaxf(mx, __shfl_xor(mx, 32));
    float l = 0.f;
#pragma unroll
    for (int rt = 0; rt < 9; ++rt)
#pragma unroll
        for (int j = 0; j < 4; ++j) { const float e = __builtin_amdgcn_exp2f(s[rt][j] - mx); s[rt][j] = e; l += e; }
    l += __shfl_xor(l, 16); l += __shfl_xor(l, 32);
#pragma unroll
    for (int ck = 0; ck < 5; ++ck) {
        u32x4 wv; wv.x = cvt_pk_bf16(s[2 * ck][0], s[2 * ck][1]); wv.y = cvt_pk_bf16(s[2 * ck][2], s[2 * ck][3]);
        if (ck < 4) { wv.z = cvt_pk_bf16(s[2 * ck + 1][0], s[2 * ck + 1][1]); wv.w = cvt_pk_bf16(s[2 * ck + 1][2], s[2 * ck + 1][3]); } else { wv.z = 0u; wv.w = 0u; }
        pk[ck] = __builtin_bit_cast(bf16x8, wv);
    }
    mx_out = mx; l_out = l;
}
template <int DH> __device__ __forceinline__ void pv(LAS const unsigned char* Vprev, LAS const unsigned char* Vcur, const bf16x8 (&pk)[5], int w, int g, int q4, int p4, f32x4 (&o)[DH / 16]) {
    const unsigned rowl = 4 * g + q4, sw = L<DH>::swz(rowl);
    LAS const unsigned char* vb[10];
#pragma unroll
    for (int rt = 0; rt < 10; ++rt) { const int kt = (w + rt) > 15 ? 15 : (w + rt); vb[rt] = ((kt < 8) ? Vprev : Vcur) + ((kt & 7) * 16 + rowl) * L<DH>::ROWB + 8 * (p4 & 1); }
#pragma unroll
    for (int c = 0; c < DH / 16; ++c) {
        const unsigned coff = 16 * ((2 * c + (p4 >> 1)) ^ sw);
        f32x4 a = (f32x4){0.f, 0.f, 0.f, 0.f};
#pragma unroll
        for (int ck = 0; ck < 5; ++ck) {
            const s16x4 t0 = __builtin_amdgcn_ds_read_tr16_b64_v4i16((LAS s16x4*)(vb[2 * ck] + coff));
            const s16x4 t1 = __builtin_amdgcn_ds_read_tr16_b64_v4i16((LAS s16x4*)(vb[2 * ck + 1] + coff));
            const bf16x8 vf = (bf16x8){t0[0], t0[1], t0[2], t0[3], t1[0], t1[1], t1[2], t1[3]};
            a = __builtin_amdgcn_mfma_f32_16x16x32_bf16(vf, pk[ck], a, 0, 0, 0);
        }
        o[c] = a;
    }
}
}

#define XB_TMO      128
#define XB_XCNT(j)  (256  + 64 * (j))
#define XB_XSUB(j)  (1280 + 64 * (j))
#define XB_XGEN(j)  (2304 + 64 * (j))
#define XB_TOP      3328
#define XB_TOPGEN   3392
#define XCD_BAR_WORDS 3456
#define XB_SPIN_CAP (1u << 18)
__device__ __forceinline__ unsigned xb_ld(unsigned* p)              { return __hip_atomic_load(p, __ATOMIC_RELAXED, __HIP_MEMORY_SCOPE_AGENT); }
__device__ __forceinline__ unsigned xb_add(unsigned* p, unsigned v) { return __hip_atomic_fetch_add(p, v, __ATOMIC_RELAXED, __HIP_MEMORY_SCOPE_AGENT); }
__device__ __forceinline__ unsigned xb_xcc_id() { return (unsigned)__builtin_amdgcn_s_getreg((3 << 11) | 20) & 0xFu; }
#define XB_SPIN(cond, bar) do { unsigned _sp = 0; while (cond) { __builtin_amdgcn_s_sleep(1); \
    if ((++_sp & 255u) == 0u) { if (xb_ld(&(bar)[XB_TMO])) break; if (_sp > XB_SPIN_CAP) { atomicAdd(&(bar)[XB_TMO], 1u); break; } } } } while (0)
struct XcdBarrier { unsigned* bar; unsigned x; volatile LAS unsigned* st; };
__device__ __forceinline__ XcdBarrier xcd_barrier_post(unsigned* bar, volatile LAS unsigned* st) {
    XcdBarrier b; b.bar = bar; b.x = xb_xcc_id(); b.st = st;
    if (threadIdx.x == 0) (void)xb_add(&bar[XB_XCNT(b.x)], 1u);
    return b;
}
__device__ __forceinline__ void xcd_barrier_complete(unsigned* bar, unsigned x, unsigned& nloc, unsigned& nx) {
    const unsigned G = gridDim.x * gridDim.y * gridDim.z;
    unsigned sum, cnt, mine, sp = 0u;
    for (;;) {
        sum = 0u; cnt = 0u; mine = 0u;
#pragma unroll
        for (unsigned j = 0; j < 16; ++j) { const unsigned c = xb_ld(&bar[XB_XCNT(j)]); sum += c; cnt += (c > 0u) ? 1u : 0u; mine = (j == x) ? c : mine; }
        if (sum == G) break;
        __builtin_amdgcn_s_sleep(1);
        if ((++sp & 255u) == 0u) { if (xb_ld(&bar[XB_TMO])) break; if (sp > XB_SPIN_CAP) { atomicAdd(&bar[XB_TMO], 1u); break; } }
    }
    nloc = mine > 0u ? mine : 1u; nx = cnt > 0u ? cnt : 1u;
}
__device__ __forceinline__ void xcd_barrier(const XcdBarrier& b) {
    asm volatile("s_waitcnt vmcnt(0)" ::: "memory");
    __syncthreads();
    if (threadIdx.x == 0) {
        unsigned* bar = b.bar;
        __builtin_amdgcn_s_waitcnt(0);
        unsigned nloc = b.st[0], nx = b.st[1];
        if (nloc == 0u) { xcd_barrier_complete(bar, b.x, nloc, nx); b.st[0] = nloc; b.st[1] = nx; }
        const unsigned old = xb_add(&bar[XB_XSUB(b.x)], 1u);
        const unsigned gen = old / nloc;
        if (old + 1u == (gen + 1u) * nloc) {
            __builtin_amdgcn_fence(__ATOMIC_RELEASE, "agent");
            asm volatile("s_waitcnt vmcnt(0)" ::: "memory");
            const unsigned og = xb_add(&bar[XB_TOP], 1u);
            const unsigned tg = og / nx;
            if (og + 1u == (tg + 1u) * nx) xb_add(&bar[XB_TOPGEN], 1u);
            else XB_SPIN(xb_ld(&bar[XB_TOPGEN]) == tg, bar);
            __builtin_amdgcn_fence(__ATOMIC_ACQUIRE, "agent");
            xb_add(&bar[XB_XGEN(b.x)], 1u);
            asm volatile("s_waitcnt vmcnt(0)" ::: "memory");
        } else {
            XB_SPIN(xb_ld(&bar[XB_XGEN(b.x)]) == gen, bar);
            __builtin_amdgcn_fence(__ATOMIC_ACQUIRE, "agent");
            asm volatile("s_waitcnt vmcnt(0)" ::: "memory");
        }
    }
    __syncthreads();
}

__device__ __forceinline__ unsigned f2bf(float f) { unsigned u = __builtin_bit_cast(unsigned, f); return (u + 0x7fffu + ((u >> 16) & 1u)) >> 16; }
__device__ __forceinline__ unsigned pk2(float lo, float hi) { return f2bf(lo) | (f2bf(hi) << 16); }
__device__ __forceinline__ void transpose_item(const float* W, int K, int N, bf16_t* WT, LAS float* scr, int item, int lane) {
    const int nblk = N / 32, kb = item / nblk, nb = item % nblk, k0 = 64 * kb, n0 = 32 * nb;
#pragma unroll 8
    for (int i = 0; i < 32; ++i) { const int kk = 2 * i + (lane >> 5); scr[kk * 33 + (lane & 31)] = W[(size_t)(k0 + kk) * N + n0 + (lane & 31)]; }
    LDS_WAIT(); asm volatile("" ::: "memory");
    const int c = lane & 7;
#pragma unroll
    for (int j = 0; j < 4; ++j) { const int n = (lane >> 3) + 8 * j; const LAS float* s = scr + (8 * c) * 33 + n;
        u32x4 o; o.x = pk2(s[0 * 33], s[1 * 33]); o.y = pk2(s[2 * 33], s[3 * 33]); o.z = pk2(s[4 * 33], s[5 * 33]); o.w = pk2(s[6 * 33], s[7 * 33]);
        *(u32x4*)(WT + (size_t)(n0 + n) * K + k0 + 8 * c) = o; }
    LDS_WAIT(); asm volatile("" ::: "memory");
}
__device__ __forceinline__ void convert_row2048(const float* src, bf16_t* dst, int lane) {
#pragma unroll
    for (int j = 0; j < 4; ++j) { const f32x4 a = *(const f32x4*)(src + 512 * j + 8 * lane), b = *(const f32x4*)(src + 512 * j + 8 * lane + 4);
        u32x4 o; o.x = pk2(a[0], a[1]); o.y = pk2(a[2], a[3]); o.z = pk2(b[0], b[1]); o.w = pk2(b[2], b[3]);
        *(u32x4*)(dst + 512 * j + 8 * lane) = o; }
}

struct Args { const float* in[19]; float* out; unsigned char* ws; float invA[16]; float invB[8]; int ph_lo, ph_hi; };
constexpr int N_PRO = 4, PPL = 11, N_PHASES = N_PRO + PPL * DEPTH;

__global__ void __launch_bounds__(NWAVES * 64, 2) fwd(Args args) {
    extern __shared__ __attribute__((aligned(16))) unsigned char lds_raw[];
    LAS unsigned char* lds = (LAS unsigned char*)lds_raw;
    volatile LAS unsigned* MISC = (volatile LAS unsigned*)(lds + MISC_OFF);
    const int tid = threadIdx.x, lane = tid & 63, wave = __builtin_amdgcn_readfirstlane(tid >> 6);
    const int G = gridDim.x, bx = blockIdx.x;
    unsigned char* ws = args.ws;
    unsigned* ctl = (unsigned*)(ws + WS_CTL);
    for (int u = tid; u < (LDS_BYTES - LDSCTL_OFF) / 4; u += NWAVES * 64) ((LAS unsigned*)(lds + LDSCTL_OFF))[u] = 0u;
    __syncthreads();
#if MK_PER_PHASE_LAUNCH
#define GRID_BAR() do { } while (0)
#else
    XcdBarrier bar = xcd_barrier_post(ctl + CW_BAR, MISC + 8);
#define GRID_BAR() xcd_barrier(bar)
#endif
    const int lo = args.ph_lo, hi = args.ph_hi;
    int ph = 0;
#define OPAQUE_LANE() int lane_ = threadIdx.x & 63; asm volatile("" : "+v"(lane_)); const int lane = lane_
#ifndef PHASE_MASK
#define PHASE_MASK 0xffffffffu
#endif
    enum { C0 = __COUNTER__ };
#define PH_BEGIN if ((((PHASE_MASK) >> (__COUNTER__ - C0 - 1)) & 1u) && ph >= lo && ph < hi) {
#define PH_END   if (ph + 1 < hi) GRID_BAR(); } ++ph;

    const float* x_in = args.in[0]; const float* mem_in = args.in[1]; const int* pos_in = (const int*)args.in[2];
    float* xf = args.out;
    bf16_t* xb = (bf16_t*)(ws + WS_XB);
    float* pre = (float*)(ws + WS_PRE);
    bf16_t* Hb = (bf16_t*)(ws + WS_H);
    bf16_t* OA = (bf16_t*)(ws + WS_OA);
    bf16_t* OB = (bf16_t*)(ws + WS_OB);
    bf16_t* Yb = (bf16_t*)(ws + WS_Y);
    bf16_t* Pb = (bf16_t*)(ws + WS_P);
    bf16_t* HID = (bf16_t*)(ws + WS_HID);
    bf16_t* KV = (bf16_t*)(ws + WS_KV);
    bf16_t* KQT = (bf16_t*)(ws + WS_KQT);
    bf16_t* VOT = (bf16_t*)(ws + WS_VOT);
    bf16_t* MEMB = (bf16_t*)(ws + WS_MEMB);
    float* tabA = (float*)(ws + WS_TABA); float* tabB = (float*)(ws + WS_TABB);
    float* statM = (float*)(ws + WS_STAT); float* statL = statM + 3 * M * 8;
    const int gw = bx * NWAVES + wave, NGW = G * NWAVES;

    PH_BEGIN
    {
        OPAQUE_LANE();
        LAS float* scr = (LAS float*)(lds + wave * 16384);
        constexpr int I_IN = 32 * 136, I_OUT = 32 * 64, I_MKV = 32 * 128, I_MO = 32 * 64, I_UP = 32 * 256, I_DOWN = 128 * 64, I_MQ = 2048;
        constexpr int I_LAYER = I_IN + I_OUT + I_MKV + I_MO + I_UP + I_DOWN + I_MQ;
        for (int it = gw; it < I_LAYER * DEPTH; it += NGW) {
            const int l = it / I_LAYER; int r = it % I_LAYER;
            unsigned char* wl = ws + WS_W + (size_t)l * WL;
            if (r < I_IN) { transpose_item(args.in[3] + (size_t)l * D * INW, D, INW, (bf16_t*)(wl + W_IN), scr, r, lane); continue; } r -= I_IN;
            if (r < I_OUT) { transpose_item(args.in[7] + (size_t)l * D * D, D, D, (bf16_t*)(wl + W_OUT), scr, r, lane); continue; } r -= I_OUT;
            if (r < I_MKV) { transpose_item(args.in[11] + (size_t)l * D * 2 * D, D, 2 * D, (bf16_t*)(wl + W_MKV), scr, r, lane); continue; } r -= I_MKV;
            if (r < I_MO) { transpose_item(args.in[12] + (size_t)l * D * D, D, D, (bf16_t*)(wl + W_MO), scr, r, lane); continue; } r -= I_MO;
            if (r < I_UP) { transpose_item(args.in[15] + (size_t)l * D * FF, D, FF, (bf16_t*)(wl + W_UP), scr, r, lane); continue; } r -= I_UP;
            if (r < I_DOWN) { transpose_item(args.in[16] + (size_t)l * FF * D, FF, D, (bf16_t*)(wl + W_DOWN), scr, r, lane); continue; } r -= I_DOWN;
            convert_row2048(args.in[10] + (size_t)l * D * D + (size_t)r * D, (bf16_t*)(wl + W_MQ) + (size_t)r * D, lane);
        }
        for (int m = gw; m < M; m += NGW) {
            const float* src = x_in + (size_t)m * D; float* dst = xf + (size_t)m * D;
#pragma unroll
            for (int j = 0; j < 8; ++j) *(f32x4*)(dst + 256 * j + 4 * lane) = *(const f32x4*)(src + 256 * j + 4 * lane);
            convert_row2048(src, xb + (size_t)m * D, lane);
        }
        for (int m = gw; m < NB * NMEM; m += NGW) convert_row2048(mem_in + (size_t)m * D, MEMB + (size_t)m * D, lane);
        for (int e = bx * 512 + wave * 64 + lane; e < M * 24; e += G * 512) {
            const int row = e / 24, i = e % 24;
            const float inv = (i < 16) ? args.invA[i] : args.invB[i - 16];
            const float ang = (float)pos_in[row] * inv;
            double rev = (double)ang * 0.15915494309189535; rev -= floor(rev);
            const float r = (float)rev;
            const float cs = __builtin_amdgcn_cosf(r), sn = __builtin_amdgcn_sinf(r);
            if (i < 16) { tabA[(size_t)row * 32 + i] = cs; tabA[(size_t)row * 32 + 16 + i] = sn; }
            else { tabB[(size_t)row * 16 + (i - 16)] = cs; tabB[(size_t)row * 16 + 8 + (i - 16)] = sn; }
        }
    }
    PH_END

    PH_BEGIN
    {
        pg8::ProbKV S{MEMB, (const bf16_t*)(ws + WS_W + W_MKV), D, D, D, G, bx};
        pg8::EpiPlain E{KV, 4096, 1.0f, 0};
        pg8::gemm_phase<pg8::EpiPlain, pg8::ProbKV, true, true>(lds, S, E);
    }
    PH_END
    PH_BEGIN
    {
        pg8::ProbKQ S{KV, ws + WS_W, 4096, 2048, 512, G, bx};
        pg8::EpiPlain E{KQT, 2048, QSM, 1};
        pg8::gemm_phase<pg8::EpiPlain, pg8::ProbKQ, true, true>(lds, S, E);
    }
    PH_END
    PH_BEGIN
    {
        pg8::ProbVO S{KV, ws + WS_W, 2048, 4096, 512, G, bx};
        pg8::EpiPlain E{VOT, 1024, 1.0f, 2};
        pg8::gemm_phase<pg8::EpiPlain, pg8::ProbVO, true, true>(lds, S, E);
    }
    PH_END

    for (int layer = 0; layer < DEPTH; ++layer) {
        const unsigned char* wl = ws + WS_W + (size_t)layer * WL;
        PH_BEGIN
        {
            pg8::ProbMain S{xb, (const bf16_t*)(wl + W_IN), D, D, D, M / 256, INW / 256, G, bx, 0};
            pg8::EpiInProj E{Hb, tabA, tabB};
            pg8::gemm_phase<pg8::EpiInProj, pg8::ProbMain, true, true>(lds, S, E);
        }
        PH_END
        PH_BEGIN
        {
            OPAQUE_LANE();
            const int g = lane >> 4, i16 = lane & 15, q4 = (lane & 15) >> 2, p4 = lane & 3;
            {
                using LA = att::L<128>;
                LAS unsigned char* Ks = lds; LAS unsigned char* Vs = lds + 2 * LA::SLOTB;
                for (int run = bx; run < 768; run += G) {
                    const int br = run >> 8, rr = run & 255;
                    int dil, chain, n0;
                    if (br == 0) { dil = 16; chain = rr; n0 = 0; }
                    else if (br == 1) { dil = 4; chain = rr >> 2; n0 = 2 * (rr & 3); }
                    else { dil = 1; chain = rr >> 4; n0 = 2 * (rr & 15); }
                    const int h = chain & 7, res = (chain >> 3) % dil, b = (chain >> 3) / dil;
                    const int brslot = (br == 0) ? 2 : (br == 1 ? 1 : 0);
                    const size_t gstride = (size_t)dil * INW;
                    const bf16_t* base = Hb + ((size_t)b * SEQ + res) * INW + h * 128;
                    if (n0 > 0) { att::dma_block<128>(Ks + ((n0 - 1) & 1) * LA::SLOTB, base + KA0 + (size_t)(n0 - 1) * 128 * gstride, gstride, wave, lane);
                                  att::dma_block<128>(Vs + ((n0 - 1) & 1) * LA::SLOTB, base + VA0 + (size_t)(n0 - 1) * 128 * gstride, gstride, wave, lane); }
                    else { att::zero_block<128>(Ks + LA::SLOTB, wave, lane); att::zero_block<128>(Vs + LA::SLOTB, wave, lane); }
                    att::dma_block<128>(Ks + (n0 & 1) * LA::SLOTB, base + KA0 + (size_t)n0 * 128 * gstride, gstride, wave, lane);
                    att::dma_block<128>(Vs + (n0 & 1) * LA::SLOTB, base + VA0 + (size_t)n0 * 128 * gstride, gstride, wave, lane);
                    for (int n = n0; n < n0 + 2; ++n) {
                        const int qi = wave * 16 + i16;
                        const size_t tok = (size_t)b * SEQ + (size_t)(n * 128 + qi) * dil + res;
                        bf16x8 qf[4];
#pragma unroll
                        for (int ss = 0; ss < 4; ++ss) qf[ss] = *(const bf16x8*)(Hb + tok * INW + QA0 + h * 128 + 32 * ss + 8 * g);
                        asm volatile("s_waitcnt vmcnt(0) lgkmcnt(0)" ::: "memory"); WG_BAR();
                        bf16x8 pk[5]; float mx, l;
                        att::scores<128>(Ks + ((n + 1) & 1) * LA::SLOTB, Ks + (n & 1) * LA::SLOTB, qf, wave, g, i16, n > 0, 0, pk, mx, l);
                        WG_BAR();
                        if (n + 1 < n0 + 2) att::dma_block<128>(Ks + ((n + 1) & 1) * LA::SLOTB, base + KA0 + (size_t)(n + 1) * 128 * gstride, gstride, wave, lane);
                        f32x4 o[8];
                        att::pv<128>(Vs + ((n + 1) & 1) * LA::SLOTB, Vs + (n & 1) * LA::SLOTB, pk, wave, g, q4, p4, o);
                        WG_BAR();
                        if (n + 1 < n0 + 2) att::dma_block<128>(Vs + ((n + 1) & 1) * LA::SLOTB, base + VA0 + (size_t)(n + 1) * 128 * gstride, gstride, wave, lane);
                        const float il = 1.0f / l;
                        bf16_t* orow = OA + ((size_t)brslot * M + tok) * 1024 + h * 128 + 4 * g;
#pragma unroll
                        for (int c = 0; c < 8; ++c) { u32x2 w; w.x = cvt_pk_bf16(o[c][0] * il, o[c][1] * il); w.y = cvt_pk_bf16(o[c][2] * il, o[c][3] * il); *(u32x2*)(orow + 16 * c) = w; }
                        if (g == 0) { statM[((size_t)brslot * M + tok) * 8 + h] = mx; statL[((size_t)brslot * M + tok) * 8 + h] = l; }
                    }
                    asm volatile("s_waitcnt vmcnt(0) lgkmcnt(0)" ::: "memory"); WG_BAR();
                }
            }
            {
                using LB = att::L<64>;
                LAS unsigned char* Ks = lds; LAS unsigned char* Vs = lds + 2 * LB::SLOTB;
                const float* sinks = args.in[6] + layer * 16;
                for (int un = bx; un < 256; un += G) {
                    const int b = un >> 7, n = (un >> 2) & 31, kvh = (un >> 1) & 1, quad = un & 1;
                    const bf16_t* base = Hb + (size_t)b * SEQ * INW;
                    if (n > 0) { att::dma_block<64>(Ks + ((n - 1) & 1) * LB::SLOTB, base + KB0 + kvh * 64 + (size_t)(n - 1) * 128 * INW, INW, wave, lane);
                                 att::dma_block<64>(Vs + ((n - 1) & 1) * LB::SLOTB, base + VB0 + kvh * 64 + (size_t)(n - 1) * 128 * INW, INW, wave, lane); }
                    else { att::zero_block<64>(Ks + LB::SLOTB, wave, lane); att::zero_block<64>(Vs + LB::SLOTB, wave, lane); }
                    att::dma_block<64>(Ks + (n & 1) * LB::SLOTB, base + KB0 + kvh * 64 + (size_t)n * 128 * INW, INW, wave, lane);
                    att::dma_block<64>(Vs + (n & 1) * LB::SLOTB, base + VB0 + kvh * 64 + (size_t)n * 128 * INW, INW, wave, lane);
                    asm volatile("s_waitcnt vmcnt(0) lgkmcnt(0)" ::: "memory"); WG_BAR();
                    const int qi = wave * 16 + i16;
                    const size_t tok = (size_t)b * SEQ + n * 128 + qi;
                    for (int qq = 0; qq < 4; ++qq) {
                        const int qh = kvh * 8 + quad * 4 + qq;
                        bf16x8 qf[2];
#pragma unroll
                        for (int ss = 0; ss < 2; ++ss) qf[ss] = *(const bf16x8*)(Hb + tok * INW + QB0 + qh * 64 + 32 * ss + 8 * g);
                        bf16x8 pk[5]; float mx, l;
                        att::scores<64>(Ks + ((n + 1) & 1) * LB::SLOTB, Ks + (n & 1) * LB::SLOTB, qf, wave, g, i16, n > 0, 1, pk, mx, l);
                        f32x4 o[4];
                        att::pv<64>(Vs + ((n + 1) & 1) * LB::SLOTB, Vs + (n & 1) * LB::SLOTB, pk, wave, g, q4, p4, o);
                        const float sk = sinks[qh] * LOG2E, m2 = fmaxf(mx, sk), cc = __builtin_amdgcn_exp2f(mx - m2), den = l * cc + __builtin_amdgcn_exp2f(sk - m2), f = cc / den;
                        bf16_t* orow = OB + tok * 1024 + qh * 64 + 4 * g;
#pragma unroll
                        for (int c = 0; c < 4; ++c) { u32x2 w; w.x = cvt_pk_bf16(o[c][0] * f, o[c][1] * f); w.y = cvt_pk_bf16(o[c][2] * f, o[c][3] * f); *(u32x2*)(orow + 16 * c) = w; }
                    }
                    asm volatile("s_waitcnt vmcnt(0) lgkmcnt(0)" ::: "memory"); WG_BAR();
                }
            }
        }
        PH_END
        PH_BEGIN
        {
            OPAQUE_LANE();
            const float* gna = args.in[4] + layer * 1024; const float* gnb = args.in[5] + layer * 1024;
            for (int m = gw; m < M; m += NGW) {
                const int h = lane >> 3;
                float mm[3], ll[3];
#pragma unroll
                for (int br = 0; br < 3; ++br) { mm[br] = statM[((size_t)br * M + m) * 8 + h]; ll[br] = statL[((size_t)br * M + m) * 8 + h]; }
                const float mxx = fmaxf(mm[0], fmaxf(mm[1], mm[2]));
                float wgt[3]; float den = 0.f;
#pragma unroll
                for (int br = 0; br < 3; ++br) { wgt[br] = ll[br] * __builtin_amdgcn_exp2f(mm[br] - mxx); den += wgt[br]; }
                const float iden = 1.0f / den;
                float ya[16];
#pragma unroll
                for (int k = 0; k < 16; ++k) ya[k] = 0.f;
#pragma unroll
                for (int br = 0; br < 3; ++br) {
                    const u32x4 a = *(const u32x4*)(OA + ((size_t)br * M + m) * 1024 + 16 * lane), b2 = *(const u32x4*)(OA + ((size_t)br * M + m) * 1024 + 16 * lane + 8);
                    const float w = wgt[br] * iden;
                    ya[0] += w * bf_lo(a.x); ya[1] += w * bf_hi(a.x); ya[2] += w * bf_lo(a.y); ya[3] += w * bf_hi(a.y); ya[4] += w * bf_lo(a.z); ya[5] += w * bf_hi(a.z); ya[6] += w * bf_lo(a.w); ya[7] += w * bf_hi(a.w);
                    ya[8] += w * bf_lo(b2.x); ya[9] += w * bf_hi(b2.x); ya[10] += w * bf_lo(b2.y); ya[11] += w * bf_hi(b2.y); ya[12] += w * bf_lo(b2.z); ya[13] += w * bf_hi(b2.z); ya[14] += w * bf_lo(b2.w); ya[15] += w * bf_hi(b2.w);
                }
                float ss = 0.f;
#pragma unroll
                for (int k = 0; k < 16; ++k) ss += ya[k] * ya[k];
                ss = wave_sum(ss);
                const float ra = 1.0f / sqrtf(ss * (1.0f / 1024.0f) + RMS_EPS);
                {
                    const f32x4 g0 = *(const f32x4*)(gna + 16 * lane), g1 = *(const f32x4*)(gna + 16 * lane + 4), g2 = *(const f32x4*)(gna + 16 * lane + 8), g3 = *(const f32x4*)(gna + 16 * lane + 12);
                    u32x4 o0, o1;
                    o0.x = cvt_pk_bf16(ya[0] * ra * g0[0], ya[1] * ra * g0[1]); o0.y = cvt_pk_bf16(ya[2] * ra * g0[2], ya[3] * ra * g0[3]);
                    o0.z = cvt_pk_bf16(ya[4] * ra * g1[0], ya[5] * ra * g1[1]); o0.w = cvt_pk_bf16(ya[6] * ra * g1[2], ya[7] * ra * g1[3]);
                    o1.x = cvt_pk_bf16(ya[8] * ra * g2[0], ya[9] * ra * g2[1]); o1.y = cvt_pk_bf16(ya[10] * ra * g2[2], ya[11] * ra * g2[3]);
                    o1.z = cvt_pk_bf16(ya[12] * ra * g3[0], ya[13] * ra * g3[1]); o1.w = cvt_pk_bf16(ya[14] * ra * g3[2], ya[15] * ra * g3[3]);
                    *(u32x4*)(Yb + (size_t)m * D + 16 * lane) = o0; *(u32x4*)(Yb + (size_t)m * D + 16 * lane + 8) = o1;
                }
                float yb[16];
                {
                    const u32x4 a = *(const u32x4*)(OB + (size_t)m * 1024 + 16 * lane), b2 = *(const u32x4*)(OB + (size_t)m * 1024 + 16 * lane + 8);
                    yb[0] = bf_lo(a.x); yb[1] = bf_hi(a.x); yb[2] = bf_lo(a.y); yb[3] = bf_hi(a.y); yb[4] = bf_lo(a.z); yb[5] = bf_hi(a.z); yb[6] = bf_lo(a.w); yb[7] = bf_hi(a.w);
                    yb[8] = bf_lo(b2.x); yb[9] = bf_hi(b2.x); yb[10] = bf_lo(b2.y); yb[11] = bf_hi(b2.y); yb[12] = bf_lo(b2.z); yb[13] = bf_hi(b2.z); yb[14] = bf_lo(b2.w); yb[15] = bf_hi(b2.w);
                }
                float sb = 0.f;
#pragma unroll
                for (int k = 0; k < 16; ++k) sb += yb[k] * yb[k];
                sb = wave_sum(sb);
                const float rb = 1.0f / sqrtf(sb * (1.0f / 1024.0f) + RMS_EPS);
                {
                    const f32x4 g0 = *(const f32x4*)(gnb + 16 * lane), g1 = *(const f32x4*)(gnb + 16 * lane + 4), g2 = *(const f32x4*)(gnb + 16 * lane + 8), g3 = *(const f32x4*)(gnb + 16 * lane + 12);
                    u32x4 o0, o1;
                    o0.x = cvt_pk_bf16(yb[0] * rb * g0[0], yb[1] * rb * g0[1]); o0.y = cvt_pk_bf16(yb[2] * rb * g0[2], yb[3] * rb * g0[3]);
                    o0.z = cvt_pk_bf16(yb[4] * rb * g1[0], yb[5] * rb * g1[1]); o0.w = cvt_pk_bf16(yb[6] * rb * g1[2], yb[7] * rb * g1[3]);
                    o1.x = cvt_pk_bf16(yb[8] * rb * g2[0], yb[9] * rb * g2[1]); o1.y = cvt_pk_bf16(yb[10] * rb * g2[2], yb[11] * rb * g2[3]);
                    o1.z = cvt_pk_bf16(yb[12] * rb * g3[0], yb[13] * rb * g3[1]); o1.w = cvt_pk_bf16(yb[14] * rb * g3[2], yb[15] * rb * g3[3]);
                    *(u32x4*)(Yb + (size_t)m * D + 1024 + 16 * lane) = o0; *(u32x4*)(Yb + (size_t)m * D + 1024 + 16 * lane + 8) = o1;
                }
            }
        }
        PH_END
#define LN_PHASE(GI, BI) { OPAQUE_LANE(); const float* lg = args.in[GI] + layer * D; const float* lb = args.in[BI] + layer * D; \
            for (int m = gw; m < M; m += NGW) { const float* src = pre + (size_t)m * D; f32x4 v[8]; float s = 0.f; \
                _Pragma("unroll") for (int j = 0; j < 8; ++j) { v[j] = *(const f32x4*)(src + 256 * j + 4 * lane); s += (v[j][0] + v[j][1]) + (v[j][2] + v[j][3]); } \
                const float mean = wave_sum(s) * (1.0f / D); float s2 = 0.f; \
                _Pragma("unroll") for (int j = 0; j < 8; ++j) { v[j] = v[j] - mean; s2 += (v[j][0] * v[j][0] + v[j][1] * v[j][1]) + (v[j][2] * v[j][2] + v[j][3] * v[j][3]); } \
                const float rstd = 1.0f / sqrtf(wave_sum(s2) * (1.0f / D) + LN_EPS); \
                _Pragma("unroll") for (int j = 0; j < 8; ++j) { const f32x4 gg = *(const f32x4*)(lg + 256 * j + 4 * lane), bb = *(const f32x4*)(lb + 256 * j + 4 * lane); \
                    const f32x4 o = v[j] * rstd * gg + bb; *(f32x4*)(xf + (size_t)m * D + 256 * j + 4 * lane) = o; \
                    u32x2 w; w.x = cvt_pk_bf16(o[0], o[1]); w.y = cvt_pk_bf16(o[2], o[3]); *(u32x2*)(xb + (size_t)m * D + 256 * j + 4 * lane) = w; } } }
        PH_BEGIN
        {
            pg8::ProbMain S{Yb, (const bf16_t*)(wl + W_OUT), D, D, D, M / 256, D / 256, G, bx, 0};
            pg8::EpiResF32 E{xf, pre, D};
            pg8::gemm_phase<pg8::EpiResF32, pg8::ProbMain, false, true>(lds, S, E);
        }
        PH_END
        PH_BEGIN
        LN_PHASE(8, 9)
        PH_END
        PH_BEGIN
        {
            pg8::ProbMain S{xb, KQT + (size_t)layer * 2 * 1024 * 2048, D, D, D, M / 256, 1024 / 256, G, bx, (size_t)1024 * 2048};
            pg8::EpiSoftmax E{Pb, 1024};
            pg8::gemm_phase<pg8::EpiSoftmax, pg8::ProbMain, false, true>(lds, S, E);
        }
        PH_END
        PH_BEGIN
        {
            pg8::ProbMain S{Pb, VOT + (size_t)layer * 2 * 2048 * 1024, 1024, 1024, 1024, M / 256, D / 256, G, bx, (size_t)2048 * 1024};
            pg8::EpiResF32 E{xf, pre, D};
            pg8::gemm_phase<pg8::EpiResF32, pg8::ProbMain, false, true>(lds, S, E);
        }
        PH_END
        PH_BEGIN
        LN_PHASE(13, 14)
        PH_END
        PH_BEGIN
        {
            pg8::ProbMain S{xb, (const bf16_t*)(wl + W_UP), D, D, D, M / 256, FF / 256, G, bx, 0};
            pg8::EpiRelu2 E{HID, FF};
            pg8::gemm_phase<pg8::EpiRelu2, pg8::ProbMain, true, true>(lds, S, E);
        }
        PH_END
        PH_BEGIN
        {
            pg8::ProbMain S{HID, (const bf16_t*)(wl + W_DOWN), FF, FF, FF, M / 256, D / 256, G, bx, 0};
            pg8::EpiResF32 E{xf, pre, D};
            pg8::gemm_phase<pg8::EpiResF32, pg8::ProbMain, false, true>(lds, S, E);
        }
        PH_END
        PH_BEGIN
        LN_PHASE(17, 18)
        PH_END
    }
}

extern "C" void kernel_launch(void* const* d_in, const int* in_sizes, int n_in, void* d_out, int out_size, void* d_ws, size_t ws_size, hipStream_t stream) {
    static int grid = 0;
    if (grid == 0) {
        if (n_in != 19 || in_sizes[0] != M * D || out_size != M * D || ws_size < WS_END) { fprintf(stderr, "kernel_launch: unexpected shapes (n_in %d, in0 %d, out %d, ws %zu < %zu); nothing launched\n", n_in, n_in > 0 ? in_sizes[0] : -1, out_size, ws_size, (size_t)WS_END); grid = -1; return; }
        int dev = 0, cus = 0, per_cu = 0;
        if (hipGetDevice(&dev) != hipSuccess || hipDeviceGetAttribute(&cus, hipDeviceAttributeMultiprocessorCount, dev) != hipSuccess) { fprintf(stderr, "kernel_launch: device query failed\n"); grid = -1; return; }
        if (hipFuncSetAttribute((const void*)fwd, hipFuncAttributeMaxDynamicSharedMemorySize, LDS_BYTES) != hipSuccess) { fprintf(stderr, "kernel_launch: hipFuncSetAttribute failed\n"); grid = -1; return; }
        if (hipOccupancyMaxActiveBlocksPerMultiprocessor(&per_cu, (const void*)fwd, NWAVES * 64, LDS_BYTES) != hipSuccess || per_cu < 1) fprintf(stderr, "kernel_launch: note: occupancy query reports %d\n", per_cu);
        (void)hipGetLastError();
        grid = cus;
    }
    if (grid < 0) return;
    if (hipMemsetAsync((char*)d_ws + WS_CTL, 0, CTL_ZERO_BYTES, stream) != hipSuccess) { fprintf(stderr, "kernel_launch: memset failed\n"); return; }
    Args a{};
    for (int i = 0; i < 19; ++i) a.in[i] = (const float*)d_in[i];
    a.out = (float*)d_out; a.ws = (unsigned char*)d_ws;
    for (int i = 0; i < 16; ++i) a.invA[i] = powf(500000.0f, -(float)(2 * i) / 32.0f);
    for (int i = 0; i < 8; ++i) a.invB[i] = powf(500000.0f, -(float)(2 * i) / 16.0f);
#if MK_PER_PHASE_LAUNCH
    for (int p = 0; p < N_PHASES; ++p) { a.ph_lo = p; a.ph_hi = p + 1; hipLaunchKernelGGL(fwd, dim3(grid), dim3(NWAVES * 64), LDS_BYTES, stream, a); }
#else
    a.ph_lo = 0; a.ph_hi = N_PHASES;
    hipLaunchKernelGGL(fwd, dim3(grid), dim3(NWAVES * 64), LDS_BYTES, stream, a);
#endif
    const hipError_t le = hipPeekAtLastError();
    if (le != hipSuccess) fprintf(stderr, "kernel_launch: launch failed: %s\n", hipGetErrorName(le));
}
```
